# Optimizing an MI355X kernel written in HIP

```python
import jax, jax.numpy as jnp
from jax import lax
import numpy as np

D_MODEL = 1024
BATCH = 8
SEQ = 2048
DEPTH = 4

N_A_LAYERS = DEPTH // 2
N_B_LAYERS = DEPTH - N_A_LAYERS
HEAD_DIM = 64
SB_HEADS = D_MODEL // HEAD_DIM
NSA_HEADS = D_MODEL // HEAD_DIM
NSA_KV_HEADS = 4
NSA_GROUP = NSA_HEADS // NSA_KV_HEADS
N_BRANCHES = 3
ROPE_DIMS = HEAD_DIM // 4
ROPE_THETA = 500000.0
D_FF = -(-8 * D_MODEL // (3 * 256)) * 256
Q_BLOCK = 128
SEL_Q_BLOCK = 64
CMP_BLOCK = 32
CMP_STRIDE = 16
CMP_HIDDEN = 4 * HEAD_DIM
SEL_BLOCK = 64
N_SEL = 8
N_LOCAL_SEL = 2
WINDOW = 512
EPS = 1e-6
NEG = -1e30
FORCE = 1e4

kernel_name = 'hybrid_stickbreak_nsa_yoco'


def _rmsnorm(x, g):
    x32 = x.astype(jnp.float32)
    y = x32 * lax.rsqrt(jnp.mean(x32 * x32, axis=-1, keepdims=True) + EPS)
    return (y * g.astype(jnp.float32)).astype(x.dtype)


def _swiglu(x, w_in, w_out):
    a, b = jnp.split(x @ w_in, 2, axis=-1)
    return (jax.nn.silu(a) * b) @ w_out


def _rope_tables(positions):
    inv_freq = jnp.power(ROPE_THETA, -jnp.arange(0, ROPE_DIMS, 2, dtype=jnp.float32) / ROPE_DIMS)
    ang = positions.astype(jnp.float32)[:, None] * inv_freq[None, :]
    return jnp.cos(ang), jnp.sin(ang)


def _apply_rope(x, cos, sin):
    half = ROPE_DIMS // 2
    x32 = x.astype(jnp.float32)
    x1, x2 = x32[..., :half], x32[..., half:ROPE_DIMS]
    c, s = cos[:, None, :], sin[:, None, :]
    return jnp.concatenate([x1 * c - x2 * s, x2 * c + x1 * s, x32[..., ROPE_DIMS:]], axis=-1).astype(x.dtype)


def _stick_breaking_attention(q, k, v):
    B, S, H, Dh = q.shape
    scale = Dh ** -0.5
    outs = []
    for start in range(0, S, Q_BLOCK):
        end = start + Q_BLOCK
        z = jnp.einsum('bthd,bshd->bhts', q[:, start:end], k[:, :end], preferred_element_type=jnp.float32) * scale
        t_pos = start + jnp.arange(Q_BLOCK)[:, None]
        s_pos = jnp.arange(end)[None, :]
        past = s_pos < t_pos
        log_1m = jnp.where(past, jax.nn.log_sigmoid(-z), 0.0)
        later = lax.cumsum(log_1m, axis=3, reverse=True) - log_1m
        w = jnp.where(past, jnp.exp(jax.nn.log_sigmoid(z) + later), 0.0)
        outs.append(jnp.einsum('bhts,bshd->bthd', w.astype(v.dtype), v[:, :end]))
    return jnp.concatenate(outs, axis=1)


def _stick_breaking_mixer(hn, w_qkv, w_out):
    B, S, _ = hn.shape
    qkv = (hn @ w_qkv).reshape(B, S, 3, SB_HEADS, HEAD_DIM)
    o = _stick_breaking_attention(qkv[:, :, 0], qkv[:, :, 1], qkv[:, :, 2])
    return o.reshape(B, S, SB_HEADS * HEAD_DIM) @ w_out


def _compress(x, pos_emb, w1, w2):
    B, S, G, Dh = x.shape
    n_cmp = (S - CMP_BLOCK) // CMP_STRIDE + 1
    idx = np.arange(n_cmp)[:, None] * CMP_STRIDE + np.arange(CMP_BLOCK)[None, :]
    blocks = x[:, idx] + pos_emb[:, None, :]
    blocks = blocks.transpose(0, 1, 3, 2, 4).reshape(B, n_cmp, G, CMP_BLOCK * Dh)
    return jax.nn.silu(blocks @ w1) @ w2


def _nsa_shared_kv(h, kv_norm, w_kv, k_norm, pos_k, pos_v, k_w1, k_w2, v_w1, v_w2, cos, sin):
    B, S, _ = h.shape
    kv = (_rmsnorm(h, kv_norm) @ w_kv).reshape(B, S, 2 * N_BRANCHES, NSA_KV_HEADS, HEAD_DIM)
    k_c_raw, v_c_raw, k_s, v_s, k_w, v_w = [kv[:, :, i] for i in range(2 * N_BRANCHES)]
    n_cmp = (S - CMP_BLOCK) // CMP_STRIDE + 1
    cc, sc = _rope_tables(jnp.arange(n_cmp) * CMP_STRIDE + (CMP_BLOCK - 1))
    k_c = _apply_rope(_rmsnorm(_compress(k_c_raw, pos_k, k_w1, k_w2), k_norm[0]), cc, sc)
    v_c = _compress(v_c_raw, pos_v, v_w1, v_w2)
    k_s = _apply_rope(_rmsnorm(k_s, k_norm[1]), cos, sin)
    k_w = _apply_rope(_rmsnorm(k_w, k_norm[2]), cos, sin)
    return (k_c, v_c, k_s, v_s, k_w, v_w)


def _nsa_selected(q, sel_idx, k_sel, v_sel):
    B, S, G, R, Dh = q.shape
    n_k = sel_idx.shape[-1]
    L = n_k * SEL_BLOCK
    scale = Dh ** -0.5
    nblk = S // SEL_Q_BLOCK
    kT = jnp.transpose(k_sel, (0, 2, 1, 3))
    vT = jnp.transpose(v_sel, (0, 2, 1, 3))
    b_ar = jnp.arange(B)[:, None, None, None]
    g_ar = jnp.arange(G)[None, :, None, None]
    offs = jnp.arange(SEL_BLOCK)
    q_blk = q.reshape(B, nblk, SEL_Q_BLOCK, G, R, Dh).transpose(1, 0, 2, 3, 4, 5)
    i_blk = sel_idx.reshape(B, G, nblk, SEL_Q_BLOCK, n_k).transpose(2, 0, 1, 3, 4)
    starts = jnp.arange(nblk) * SEL_Q_BLOCK

    def one_block(args):
        qb, ib, t0 = args
        tok = (ib[..., None] * SEL_BLOCK + offs).reshape(B, G, SEL_Q_BLOCK, L)
        kg = kT[b_ar, g_ar, tok]
        vg = vT[b_ar, g_ar, tok]
        s = jnp.einsum('btgrd,bgtld->bgrtl', qb, kg, preferred_element_type=jnp.float32) * scale
        t_pos = t0 + jnp.arange(SEL_Q_BLOCK)
        mask = tok[:, :, None] <= t_pos[:, None]
        p = jax.nn.softmax(jnp.where(mask, s, NEG), axis=-1)
        return jnp.einsum('bgrtl,bgtld->btgrd', p.astype(vg.dtype), vg)

    out = lax.map(one_block, (q_blk, i_blk, starts))
    return out.transpose(1, 0, 2, 3, 4, 5).reshape(B, S, G, R, Dh)


def _nsa_window(q, k_win, v_win):
    B, S, G, R, Dh = q.shape
    scale = Dh ** -0.5
    nblk = S // Q_BLOCK
    span = WINDOW + Q_BLOCK
    k_pad = jnp.pad(k_win, ((0, 0), (WINDOW, 0), (0, 0), (0, 0)))
    v_pad = jnp.pad(v_win, ((0, 0), (WINDOW, 0), (0, 0), (0, 0)))
    q_blk = q.reshape(B, nblk, Q_BLOCK, G, R, Dh).transpose(1, 0, 2, 3, 4, 5)
    starts = jnp.arange(nblk) * Q_BLOCK

    def one_block(args):
        qb, t0 = args
        kb = lax.dynamic_slice_in_dim(k_pad, t0, span, axis=1)
        vb = lax.dynamic_slice_in_dim(v_pad, t0, span, axis=1)
        s = jnp.einsum('btgrd,bsgd->bgrts', qb, kb, preferred_element_type=jnp.float32) * scale
        t_pos = t0 + jnp.arange(Q_BLOCK)[:, None]
        s_pos = t0 - WINDOW + jnp.arange(span)[None, :]
        mask = (s_pos <= t_pos) & (t_pos - s_pos < WINDOW) & (s_pos >= 0)
        p = jax.nn.softmax(jnp.where(mask, s, NEG), axis=-1)
        return jnp.einsum('bgrts,bsgd->btgrd', p.astype(vb.dtype), vb)

    out = lax.map(one_block, (q_blk, starts))
    return out.transpose(1, 0, 2, 3, 4, 5).reshape(B, S, G, R, Dh)


def _nsa_mixer(hn, kvs, w_in, q_norm, w_out, cos, sin):
    k_c, v_c, k_s, v_s, k_w, v_w = kvs
    B, S, _ = hn.shape
    G, R, Dh = NSA_KV_HEADS, NSA_GROUP, HEAD_DIM
    scale = Dh ** -0.5
    proj = hn @ w_in
    q = proj[..., :NSA_HEADS * Dh].reshape(B, S, NSA_HEADS, Dh)
    q = _apply_rope(_rmsnorm(q, q_norm), cos, sin).reshape(B, S, G, R, Dh)
    gates = jax.nn.sigmoid(proj[..., NSA_HEADS * Dh:].astype(jnp.float32)).reshape(B, S, N_BRANCHES, G, R)
    t_pos = jnp.arange(S)
    n_cmp = k_c.shape[1]
    s_c = jnp.einsum('btgrd,bcgd->bgrtc', q, k_c, preferred_element_type=jnp.float32) * scale
    c_end = jnp.arange(n_cmp) * CMP_STRIDE + (CMP_BLOCK - 1)
    valid_c = c_end[None, :] <= t_pos[:, None]
    p_c = jax.nn.softmax(jnp.where(valid_c, s_c, NEG), axis=-1) * jnp.any(valid_c, axis=-1)[:, None]
    o_c = jnp.einsum('bgrtc,bcgd->btgrd', p_c.astype(v_c.dtype), v_c)
    n_sel = S // SEL_BLOCK
    c_start = np.arange(n_cmp) * CMP_STRIDE
    j_start = np.arange(n_sel) * SEL_BLOCK
    overlap = ((c_start[:, None] < j_start[None, :] + SEL_BLOCK)
               & (c_start[:, None] + CMP_BLOCK > j_start[None, :])).astype(np.float32)
    imp = jnp.einsum('bgrtc,cj->bgtj', p_c, jnp.asarray(overlap))
    j = jnp.arange(n_sel)[None, :]
    cur = (t_pos // SEL_BLOCK)[:, None]
    forced = (j == 0) | ((cur - j >= 0) & (cur - j < N_LOCAL_SEL))
    sel_score = jnp.where(forced, FORCE, jnp.where(j <= cur, imp, -FORCE))
    _, sel_idx = lax.top_k(sel_score, min(N_SEL, n_sel))
    o_s = _nsa_selected(q, sel_idx, k_s, v_s)
    o_w = _nsa_window(q, k_w, v_w)
    o = (gates[:, :, 0, :, :, None] * o_c + gates[:, :, 1, :, :, None] * o_s
         + gates[:, :, 2, :, :, None] * o_w).astype(hn.dtype)
    return o.reshape(B, S, NSA_HEADS * Dh) @ w_out


def setup_inputs(seed: int = 0) -> dict:
    key = jax.random.key(seed)
    ks = jax.random.split(key, 22)
    f32 = jnp.float32

    def dense(k, shape):
        return jax.random.normal(k, shape, f32) * shape[-2] ** -0.5

    def gain(k, shape):
        return 1.0 + 0.02 * jax.random.normal(k, shape, f32)

    H, G, Dh = NSA_HEADS, NSA_KV_HEADS, HEAD_DIM
    return {
        'x': jax.random.normal(ks[0], (BATCH, SEQ, D_MODEL), f32),
        'ffn1_norm': gain(ks[1], (DEPTH, D_MODEL)),
        'ffn1_w_in': dense(ks[2], (DEPTH, D_MODEL, 2 * D_FF)),
        'ffn1_w_out': dense(ks[3], (DEPTH, D_FF, D_MODEL)),
        'mix_norm': gain(ks[4], (DEPTH, D_MODEL)),
        'ffn2_norm': gain(ks[5], (DEPTH, D_MODEL)),
        'ffn2_w_in': dense(ks[6], (DEPTH, D_MODEL, 2 * D_FF)),
        'ffn2_w_out': dense(ks[7], (DEPTH, D_FF, D_MODEL)),
        'sb_w_qkv': dense(ks[8], (N_A_LAYERS, D_MODEL, 3 * SB_HEADS * Dh)),
        'sb_w_out': dense(ks[9], (N_A_LAYERS, SB_HEADS * Dh, D_MODEL)),
        'kv_norm': gain(ks[10], (D_MODEL,)),
        'nsa_w_kv': dense(ks[11], (D_MODEL, 2 * N_BRANCHES * G * Dh)),
        'nsa_k_norm': gain(ks[12], (N_BRANCHES, Dh)),
        'cmp_pos_k': 0.1 * jax.random.normal(ks[13], (CMP_BLOCK, Dh), f32),
        'cmp_pos_v': 0.1 * jax.random.normal(ks[14], (CMP_BLOCK, Dh), f32),
        'cmp_k_w1': dense(ks[15], (CMP_BLOCK * Dh, CMP_HIDDEN)),
        'cmp_k_w2': dense(ks[16], (CMP_HIDDEN, Dh)),
        'cmp_v_w1': dense(ks[17], (CMP_BLOCK * Dh, CMP_HIDDEN)),
        'cmp_v_w2': dense(ks[18], (CMP_HIDDEN, Dh)),
        'nsa_w_in': dense(ks[19], (N_B_LAYERS, D_MODEL, H * Dh + N_BRANCHES * H)),
        'nsa_q_norm': gain(ks[20], (N_B_LAYERS, Dh)),
        'nsa_w_out': dense(ks[21], (N_B_LAYERS, H * Dh, D_MODEL)),
    }


def reference(x, ffn1_norm, ffn1_w_in, ffn1_w_out, mix_norm, ffn2_norm, ffn2_w_in, ffn2_w_out,
              sb_w_qkv, sb_w_out, kv_norm, nsa_w_kv, nsa_k_norm, cmp_pos_k, cmp_pos_v,
              cmp_k_w1, cmp_k_w2, cmp_v_w1, cmp_v_w2, nsa_w_in, nsa_q_norm, nsa_w_out):
    B, S, _ = x.shape
    cos, sin = _rope_tables(jnp.arange(S))
    h = x
    kvs = None
    for layer in range(DEPTH):
        h = h + 0.5 * _swiglu(_rmsnorm(h, ffn1_norm[layer]), ffn1_w_in[layer], ffn1_w_out[layer])
        hn = _rmsnorm(h, mix_norm[layer])
        if layer < N_A_LAYERS:
            h = h + _stick_breaking_mixer(hn, sb_w_qkv[layer], sb_w_out[layer])
        else:
            i = layer - N_A_LAYERS
            h = h + _nsa_mixer(hn, kvs, nsa_w_in[i], nsa_q_norm[i], nsa_w_out[i], cos, sin)
        h = h + 0.5 * _swiglu(_rmsnorm(h, ffn2_norm[layer]), ffn2_w_in[layer], ffn2_w_out[layer])
        if layer == N_A_LAYERS - 1:
            kvs = _nsa_shared_kv(h, kv_norm, nsa_w_kv, nsa_k_norm, cmp_pos_k, cmp_pos_v,
                                 cmp_k_w1, cmp_k_w2, cmp_v_w1, cmp_v_w2, cos, sin)
    return h
```

```cpp
#include <hip/hip_runtime.h>
#include <hip/hip_cooperative_groups.h>
#include <cstdio>
#include <cstdint>
namespace cg = cooperative_groups;

#ifndef MK_COOP
#define MK_COOP 1
#endif

#define LAS __attribute__((address_space(3)))
typedef unsigned short bf16_t;
typedef short bf16x8 __attribute__((ext_vector_type(8)));
typedef short s16x4 __attribute__((ext_vector_type(4)));
typedef float f32x4 __attribute__((ext_vector_type(4)));
typedef float f32x16 __attribute__((ext_vector_type(16)));
typedef unsigned u32x4 __attribute__((ext_vector_type(4)));
typedef unsigned u32x2 __attribute__((ext_vector_type(2)));
typedef __bf16 bfv2 __attribute__((ext_vector_type(2)));
typedef float f32x2 __attribute__((ext_vector_type(2)));
#define DI __device__ __forceinline__
#define GAS __attribute__((address_space(1)))
template <class T> __device__ __forceinline__ const GAS T* gp(const T* p) { return (const GAS T*)p; }
template <class T> __device__ __forceinline__ GAS T* gpw(T* p) { return (GAS T*)p; }
#define MFMA32(a, b, c) __builtin_amdgcn_mfma_f32_32x32x16_bf16((a), (b), (c), 0, 0, 0)

constexpr int DM = 1024, NBATCH = 8, SEQ = 2048, MTOK = NBATCH * SEQ, DFF = 2816, NUP = 2 * DFF;
constexpr size_t MiB = 1ull << 20;
constexpr size_t WS_ROPE = 0, WS_BAR = 1 * MiB, WS_H = 2 * MiB, WS_HB = 66 * MiB, WS_W1IN = 98 * MiB, WS_W1OUT = 109 * MiB, WS_W2IN = 115 * MiB,
                 WS_W2OUT = 126 * MiB, WS_WMIX = 132 * MiB, WS_WKV = 140 * MiB, WS_KVN = 146 * MiB, WS_KVT = 178 * MiB, WS_KC = 194 * MiB,
                 WS_VCT = 194 * MiB + 512 * 1024, WS_S = 196 * MiB, WS_RP = 324 * MiB, WS_CMP = 326 * MiB, WS_END = 362 * MiB;
constexpr int NPH = 30;
constexpr int LDS_STAGE = 131072, LDS_RQ = LDS_STAGE + 64, LDS_BYTES = LDS_RQ + 4096;

struct Params { const float* in[22]; float* out; unsigned char* ws; };
struct Ctx { int tid, bid, nb, plo, phi, pq, pst; };
#define IN(i) launder_ptr(p.in[i])
__device__ __forceinline__ unsigned launder_u32(unsigned x) { unsigned y; asm volatile("v_mov_b32 %0, %1" : "=v"(y) : "s"(x)); return __builtin_amdgcn_readfirstlane(y); }
template <class T> __device__ __forceinline__ T* launder_ptr(T* p) { const unsigned long long v = (unsigned long long)p; const unsigned lo = launder_u32((unsigned)v), hi = launder_u32((unsigned)(v >> 32)); return (T*)(((unsigned long long)hi << 32) | lo); }

DI unsigned pk2(float lo, float hi) { f32x2 v = {lo, hi}; bfv2 b = __builtin_convertvector(v, bfv2); return __builtin_bit_cast(unsigned, b); }
DI float bf2f(unsigned short b) { return __uint_as_float(((unsigned)b) << 16); }
DI float bflo(unsigned u) { return __uint_as_float(u << 16); }
DI float bfhi(unsigned u) { return __uint_as_float(u & 0xffff0000u); }
typedef unsigned long long u64;
DI float rstd_of(const u64* p) { const float ss = (float)(*p) * (1.0f / 1048576.0f); return rsqrtf(ss * (1.0f / 1024.0f) + 1e-6f); }
DI u64 ss_fix(float ss) { return (u64)(ss * 1048576.0f + 0.5f); }
DI void lds_barrier() { asm volatile("s_waitcnt lgkmcnt(0)" ::: "memory"); __builtin_amdgcn_s_barrier(); asm volatile("" ::: "memory"); }
DI float silu_f(float a) { return a * __builtin_amdgcn_rcpf(1.0f + __expf(-a)); }

namespace pg8 {
constexpr int BM = 256, BK = 64, HALF = 128, HTB = HALF * BK * 2, STAGE_BYTES = 8 * HTB, NXCD = 8, WGM = 8;
DI int lds_byte(int r, int c) { const int st = (r >> 4) * 2 + (c >> 5), rr = r & 15, cc = c & 31, ob = rr * 64 + cc * 2; return st * 1024 + (ob ^ (((ob >> 9) & 1) << 5)); }
DI void stage_rc(int b, int& R, int& C) { const int st = b / 1024, sb = b % 1024, swz = sb ^ (((sb >> 9) & 1) << 5); R = (st >> 1) * 16 + swz / 64; C = (st & 1) * 32 + (swz % 64) / 2; }
DI int perm32(int rho) { const int n = rho >> 4, i = rho & 15; return 8 * (i >> 2) + 4 * n + (i & 3); }
struct Unit { int pm, pn; };
struct Gemm { const bf16_t* A; const bf16_t* Bt; int M, N, K; };
struct StaticOrder {
    int nM, nN, nwg, G, c;
    DI void init(int M, int N, int G_, int c_) { nM = M / BM; nN = N / BM; nwg = nM * nN; G = G_; c = c_; }
    DI bool next(int i, Unit& u) const {
        const long L = (long)i * G + c; if (L >= nwg) return false;
        int wgid = (int)L; { const int q = nwg / NXCD, r = nwg % NXCD, xcd = wgid % NXCD, off = wgid / NXCD; wgid = (xcd < r ? xcd * (q + 1) : r * (q + 1) + (xcd - r) * q) + off; }
        const int nig = WGM * nN, gid = wgid / nig, fm = gid * WGM, gsz = (nM - fm) < WGM ? (nM - fm) : WGM;
        u.pm = fm + ((wgid % nig) % gsz); u.pn = (wgid % nig) / gsz; return true;
    }
};

enum { EP_U = 0, EP_RES = 1, EP_SCALE = 2, EP_SCALET = 3, EP_SILU = 4 };
struct EpiKey { unsigned char* ws; float* out; const float* x; int L, k, i, nb; };
struct EpiFields { const u64* rowss; bf16_t* ob; int ldo; const float* hsrc; float* hdst; bf16_t* hb; void* hlo; u64* rowss_out; float alpha; };
DI void epi_resolve(const EpiKey& key, EpiFields& f);
template <int MODE> struct Epi {
    static constexpr bool PERM = true;
    static constexpr bool HAS_RQ = (MODE == EP_U || MODE == EP_SCALE);
    EpiKey key;
    DI void operator()(const f32x4 (&acc)[2][2][4][2], const Unit& u, int wr, int wc, int fr, int fq, const LAS unsigned char* rqL) const {
        EpiFields F; epi_resolve(key, F);
        const u64* rowss = F.rowss; bf16_t* ob = F.ob; const int ldo = F.ldo; const float* hsrc = F.hsrc; float* hdst = F.hdst; bf16_t* hb = F.hb; u64* rowss_out = F.rowss_out; const float alpha = F.alpha;
        if constexpr (MODE == EP_U) {
            const int row0 = u.pm * BM + wr * 64 + fr, col0 = u.pn * 128 + wc * 32 + 8 * fq;
            u64 rq[2][4];
#pragma unroll
            for (int ai = 0; ai < 2; ++ai)
#pragma unroll
                for (int m = 0; m < 4; ++m) rq[ai][m] = *(const LAS u64*)(rqL + (wr * 64 + fr + ai * HALF + m * 16) * 8);
#pragma unroll
            for (int ai = 0; ai < 2; ++ai)
#pragma unroll
                for (int m = 0; m < 4; ++m) {
                    const int row = row0 + ai * HALF + m * 16; const float rs = rstd_of(&rq[ai][m]);
                    float o[8];
#pragma unroll
                    for (int n = 0; n < 2; ++n)
#pragma unroll
                        for (int j = 0; j < 4; ++j) { const float a = acc[ai][0][m][n][j] * rs, b = acc[ai][1][m][n][j] * rs; o[4 * n + j] = silu_f(a) * b; }
                    u32x4 w; w.x = pk2(o[0], o[1]); w.y = pk2(o[2], o[3]); w.z = pk2(o[4], o[5]); w.w = pk2(o[6], o[7]);
                    *gpw((u32x4*)(ob + (size_t)row * ldo + col0)) = w;
                }
        } else if constexpr (MODE == EP_RES) {
            const int row0 = u.pm * BM + wr * 64 + fr, col0 = u.pn * BM + wc * 32 + 8 * fq;
            bf16_t* lo = (bf16_t*)F.hlo;
            u32x4 ld0[2][2], ld1[2][2];
            auto issue = [&](int am, int slot) {
                const int ai = am >> 2, m = am & 3;
#pragma unroll
                for (int bj = 0; bj < 2; ++bj) {
                    const size_t off = (size_t)(row0 + ai * HALF + m * 16) * DM + col0 + bj * HALF;
                    if (hsrc) { ld0[slot][bj] = *gp((const u32x4*)(hsrc + off)); ld1[slot][bj] = *gp((const u32x4*)(hsrc + off + 4)); }
                    else { ld0[slot][bj] = *gp((const u32x4*)(hb + off)); ld1[slot][bj] = *gp((const u32x4*)(lo + off)); }
                }
            };
            issue(0, 0);
#pragma unroll
            for (int am = 0; am < 8; ++am) {
                const int ai = am >> 2, m = am & 3, slot = am & 1;
                const int row = row0 + ai * HALF + m * 16; float ss = 0.f;
                if (am + 1 < 8) issue(am + 1, slot ^ 1);
#pragma unroll
                for (int bj = 0; bj < 2; ++bj) {
                    const size_t off = (size_t)row * DM + col0 + bj * HALF;
                    float v[8];
                    if (hsrc) {
#pragma unroll
                        for (int j = 0; j < 4; ++j) { v[j] = __uint_as_float(ld0[slot][bj][j]); v[4 + j] = __uint_as_float(ld1[slot][bj][j]); }
                    } else {
#pragma unroll
                        for (int q = 0; q < 4; ++q) { v[2 * q] = bflo(ld0[slot][bj][q]) + bflo(ld1[slot][bj][q]); v[2 * q + 1] = bfhi(ld0[slot][bj][q]) + bfhi(ld1[slot][bj][q]); }
                    }
#pragma unroll
                    for (int n = 0; n < 2; ++n)
#pragma unroll
                        for (int j = 0; j < 4; ++j) { v[4 * n + j] += alpha * acc[ai][bj][m][n][j]; ss += v[4 * n + j] * v[4 * n + j]; }
                    if (hdst) {
                        f32x4 a, b;
#pragma unroll
                        for (int j = 0; j < 4; ++j) { a[j] = v[j]; b[j] = v[4 + j]; }
                        *gpw((f32x4*)(hdst + off)) = a; *gpw((f32x4*)(hdst + off + 4)) = b;
                    } else {
                        u32x4 hi4, lo4;
#pragma unroll
                        for (int q = 0; q < 4; ++q) { hi4[q] = pk2(v[2 * q], v[2 * q + 1]); lo4[q] = pk2(v[2 * q] - bflo(hi4[q]), v[2 * q + 1] - bfhi(hi4[q])); }
                        *gpw((u32x4*)(hb + off)) = hi4; *gpw((u32x4*)(lo + off)) = lo4;
                    }
                }
                if (rowss_out) { ss += __shfl_xor(ss, 16); ss += __shfl_xor(ss, 32); if (fq == 0) (void)__hip_atomic_fetch_add(gpw(rowss_out + row), ss_fix(ss), __ATOMIC_RELAXED, __HIP_MEMORY_SCOPE_AGENT); }
            }
        } else if constexpr (MODE == EP_SCALE || MODE == EP_SILU) {
            const int row0 = u.pm * BM + wr * 64 + fr, col0 = u.pn * BM + wc * 32 + 8 * fq;
            u64 rq[2][4];
#pragma unroll
            for (int ai = 0; ai < 2; ++ai)
#pragma unroll
                for (int m = 0; m < 4; ++m) { if constexpr (MODE == EP_SCALE) rq[ai][m] = *(const LAS u64*)(rqL + (wr * 64 + fr + ai * HALF + m * 16) * 8); else rq[ai][m] = 1ull; }
#pragma unroll
            for (int ai = 0; ai < 2; ++ai)
#pragma unroll
                for (int m = 0; m < 4; ++m) {
                    const int row = row0 + ai * HALF + m * 16; float rs = 1.f; if constexpr (MODE == EP_SCALE) rs = rstd_of(&rq[ai][m]);
#pragma unroll
                    for (int bj = 0; bj < 2; ++bj) {
                        float o[8];
#pragma unroll
                        for (int n = 0; n < 2; ++n)
#pragma unroll
                            for (int j = 0; j < 4; ++j) { float a = acc[ai][bj][m][n][j] * rs; if constexpr (MODE == EP_SILU) a = silu_f(a); o[4 * n + j] = a; }
                        u32x4 w; w.x = pk2(o[0], o[1]); w.y = pk2(o[2], o[3]); w.z = pk2(o[4], o[5]); w.w = pk2(o[6], o[7]);
                        *gpw((u32x4*)(ob + (size_t)row * ldo + col0 + bj * HALF)) = w;
                    }
                }
        } else {
            const int row0 = u.pm * BM + wr * 64 + fr, col0 = u.pn * BM + wc * 32 + 8 * fq;
            float rs[2][8]; u64 rq[2][8];
#pragma unroll
            for (int bj = 0; bj < 2; ++bj)
#pragma unroll
                for (int j = 0; j < 8; ++j) rq[bj][j] = *gp(rowss + col0 + bj * HALF + j);
#pragma unroll
            for (int bj = 0; bj < 2; ++bj)
#pragma unroll
                for (int j = 0; j < 8; ++j) rs[bj][j] = rstd_of(&rq[bj][j]);
#pragma unroll
            for (int ai = 0; ai < 2; ++ai)
#pragma unroll
                for (int m = 0; m < 4; ++m) {
                    const int row = row0 + ai * HALF + m * 16;
#pragma unroll
                    for (int bj = 0; bj < 2; ++bj) {
                        float o[8];
#pragma unroll
                        for (int n = 0; n < 2; ++n)
#pragma unroll
                            for (int j = 0; j < 4; ++j) o[4 * n + j] = acc[ai][bj][m][n][j] * rs[bj][4 * n + j];
                        u32x4 w; w.x = pk2(o[0], o[1]); w.y = pk2(o[2], o[3]); w.z = pk2(o[4], o[5]); w.w = pk2(o[6], o[7]);
                        *gpw((u32x4*)(ob + (size_t)row * ldo + col0 + bj * HALF)) = w;
                    }
                }
        }
    }
};

template <class EpiT>
DI void gemm_phase(const Ctx& cx, LAS unsigned char* lds, const Gemm g, const StaticOrder& S, const EpiT& E, const u64* rqbase = nullptr) {
    const int tid = cx.tid, wid = __builtin_amdgcn_readfirstlane(tid >> 6), lane = tid & 63, wr = wid >> 2, wc = wid & 3, fr = lane & 15, fq = lane >> 4;
    const int K = g.K, nt = K / BK;
    unsigned voffA[2], voffB[2];
#pragma unroll
    for (int i = 0; i < 2; ++i) { int R, C; stage_rc(tid * 16 + i * 8192, R, C); const int Rb = EpiT::PERM ? ((R & ~31) + perm32(R & 31)) : R;
        voffA[i] = (unsigned)(R * K + C) * 2u; voffB[i] = (unsigned)(Rb * K + C) * 2u; }
    const size_t kstep = (size_t)(BK * 2);
    const size_t hstep = (size_t)HALF * K * 2;
    const size_t tstep = 2 * hstep;
    const unsigned ldsw = (unsigned)wid * 1024u;
    const int aoff = lds_byte(wr * 64 + fr, fq * 8), boff = lds_byte(wc * 32 + fr, fq * 8);
#define PG8_SA(b, h) (((b) * 2 + (h)) * HTB)
#define PG8_SB(b, h) ((4 + (b) * 2 + (h)) * HTB)
#define PG8_STAGE(bufoff, gbase, voff) do { _Pragma("unroll") for (int _i = 0; _i < 2; ++_i) \
        __builtin_amdgcn_global_load_lds((const unsigned*)((const char*)(gbase) + (voff)[_i]), (LAS unsigned*)(lds + (bufoff) + ldsw + _i * 8192), 16, 0, 0); } while (0)
#define PG8_LDA(dst, b, h) do { _Pragma("unroll") for (int m = 0; m < 4; ++m) _Pragma("unroll") for (int k = 0; k < 2; ++k) dst[m][k] = *(const LAS bf16x8*)(lds + PG8_SA(b, h) + aoff + m * 2048 + k * 1024); } while (0)
#define PG8_LDB(dst, b, h) do { _Pragma("unroll") for (int n = 0; n < 2; ++n) _Pragma("unroll") for (int k = 0; k < 2; ++k) dst[n][k] = *(const LAS bf16x8*)(lds + PG8_SB(b, h) + boff + n * 2048 + k * 1024); } while (0)
#define PG8_MMA(ai, bj, At, Bt) do { __builtin_amdgcn_s_setprio(1); _Pragma("unroll") for (int m = 0; m < 4; ++m) _Pragma("unroll") for (int n = 0; n < 2; ++n) _Pragma("unroll") for (int k = 0; k < 2; ++k) \
        acc[ai][bj][m][n] = __builtin_amdgcn_mfma_f32_16x16x32_bf16(Bt[n][k], At[m][k], acc[ai][bj][m][n], 0, 0, 0); __builtin_amdgcn_s_setprio(0); } while (0)
#define PG8_WAIT_V(n) asm volatile("s_waitcnt vmcnt(" #n ")" ::: "memory")
#define PG8_WAIT_L(n) asm volatile("s_waitcnt lgkmcnt(" #n ")" ::: "memory")
#define PG8_BAR __builtin_amdgcn_s_barrier()
#define PG8_SCHED __builtin_amdgcn_sched_barrier(0)
    Unit cur, nxt; int ui = 0;
    if (!S.next(0, cur)) return;
    f32x4 acc[2][2][4][2];
#pragma unroll
    for (int a = 0; a < 2; ++a)
#pragma unroll
        for (int b = 0; b < 2; ++b)
#pragma unroll
            for (int m = 0; m < 4; ++m)
#pragma unroll
                for (int n = 0; n < 2; ++n) acc[a][b][m][n] = (f32x4){0.f, 0.f, 0.f, 0.f};
    bf16x8 At[4][2], B0[2][2], B1[2][2];
    const char* cA = (const char*)g.A + (size_t)cur.pm * tstep; const char* cB = (const char*)g.Bt + (size_t)cur.pn * tstep;
#define PG8_RQ(unit, par) do { if (EpiT::HAS_RQ && wid < 2) __builtin_amdgcn_global_load_lds((const unsigned*)(rqbase + (unit).pm * BM + 128 * wid + 2 * lane), \
        (LAS unsigned*)(lds + LDS_RQ + (par) * 2048 + wid * 1024), 16, 0, 0); } while (0)
    PG8_RQ(cur, 0);
    PG8_STAGE(PG8_SB(0, 0), cB, voffB); PG8_STAGE(PG8_SA(0, 0), cA, voffA); PG8_STAGE(PG8_SB(0, 1), cB + hstep, voffB); PG8_STAGE(PG8_SA(0, 1), cA + hstep, voffA);
    if (wr == 1) PG8_BAR;
    PG8_WAIT_V(4); PG8_BAR;
    PG8_STAGE(PG8_SB(1, 0), cB + kstep, voffB); PG8_STAGE(PG8_SA(1, 0), cA + kstep, voffA); PG8_STAGE(PG8_SB(1, 1), cB + hstep + kstep, voffB);
    PG8_WAIT_V(6); PG8_BAR;
    for (;;) {
        const bool has_next = S.next(ui + 1, nxt);
        const char* nA = has_next ? (const char*)g.A + (size_t)nxt.pm * tstep : cA; const char* nB = has_next ? (const char*)g.Bt + (size_t)nxt.pn * tstep : cB;
        for (int t = 0; t < nt; t += 2) {
            const bool last = (t == nt - 2);
            const char* a1 = cA + (size_t)(t + 1) * kstep;
            const char* a2 = last ? nA : cA + (size_t)(t + 2) * kstep; const char* b2 = last ? nB : cB + (size_t)(t + 2) * kstep;
            const char* a3 = a2 + kstep; const char* b3 = b2 + kstep;
            PG8_LDB(B0, 0, 0); PG8_SCHED; PG8_LDA(At, 0, 0); PG8_STAGE(PG8_SA(1, 1), a1 + hstep, voffA);
            PG8_WAIT_L(8); PG8_BAR; PG8_WAIT_L(0); PG8_MMA(0, 0, At, B0); PG8_BAR; PG8_SCHED;
            PG8_LDB(B1, 0, 1); PG8_STAGE(PG8_SB(0, 0), b2, voffB);
            PG8_BAR; PG8_WAIT_L(0); PG8_MMA(0, 1, At, B1); PG8_BAR;
            PG8_LDA(At, 0, 1); PG8_STAGE(PG8_SA(0, 0), a2, voffA);
            PG8_BAR; PG8_WAIT_L(0); PG8_MMA(1, 0, At, B0); PG8_BAR; PG8_SCHED;
            PG8_STAGE(PG8_SB(0, 1), b2 + hstep, voffB);
            PG8_WAIT_V(6); PG8_BAR; PG8_MMA(1, 1, At, B1); PG8_BAR;
            PG8_LDB(B0, 1, 0); PG8_SCHED; PG8_LDA(At, 1, 0); PG8_STAGE(PG8_SA(0, 1), a2 + hstep, voffA);
            PG8_WAIT_L(8); PG8_BAR; PG8_WAIT_L(0); PG8_MMA(0, 0, At, B0); PG8_BAR; PG8_SCHED;
            PG8_LDB(B1, 1, 1); PG8_STAGE(PG8_SB(1, 0), b3, voffB);
            PG8_BAR; PG8_WAIT_L(0); PG8_MMA(0, 1, At, B1); PG8_BAR;
            PG8_LDA(At, 1, 1); PG8_STAGE(PG8_SA(1, 0), a3, voffA);
            PG8_BAR; PG8_WAIT_L(0); PG8_MMA(1, 0, At, B0); PG8_BAR; PG8_SCHED;
            PG8_STAGE(PG8_SB(1, 1), b3 + hstep, voffB);
            PG8_WAIT_V(6); PG8_BAR; PG8_MMA(1, 1, At, B1); PG8_BAR;
        }
        E(acc, cur, wr, wc, fr, fq, lds + LDS_RQ + (ui & 1) * 2048);
        if (has_next) PG8_RQ(nxt, (ui + 1) & 1);
        if (!has_next) break;
#pragma unroll
        for (int a = 0; a < 2; ++a)
#pragma unroll
            for (int b = 0; b < 2; ++b)
#pragma unroll
                for (int m = 0; m < 4; ++m)
#pragma unroll
                    for (int n = 0; n < 2; ++n) acc[a][b][m][n] = (f32x4){0.f, 0.f, 0.f, 0.f};
        cur = nxt; cA = nA; cB = nB; ++ui;
    }
    PG8_WAIT_V(0);
    if (wr == 0) PG8_BAR;
    PG8_BAR;
#undef PG8_RQ
#undef PG8_SA
#undef PG8_SB
#undef PG8_STAGE
#undef PG8_LDA
#undef PG8_LDB
#undef PG8_MMA
#undef PG8_WAIT_V
#undef PG8_WAIT_L
#undef PG8_BAR
#undef PG8_SCHED
}
}

template <int MODE>
DI void run_gemm(const Ctx& cx, LAS unsigned char* lds, const bf16_t* A, const bf16_t* Bt, int M, int N, int K, const pg8::Epi<MODE>& E) {
    pg8::Gemm g; g.A = A; g.Bt = Bt; g.M = M; g.N = N; g.K = K;
    pg8::StaticOrder S; S.init(M, N, (int)cx.nb, (int)cx.bid);
    pg8::gemm_phase(cx, lds, g, S, E);
}

DI void transpose_load(const float* __restrict__ src, int ld, int ntk, int type, int col0, int nvalid, const float* __restrict__ gain, int t, int n4, int kq, f32x4 (&v)[4], float (&gv)[4]) {
    const int tn = t / ntk, tk = t - tn * ntk;
    const int n0 = tn * 64, k0 = tk * 128;
    int c0;
    if (type == 1) { const int pn = n0 >> 8, w = n0 & 255; c0 = (w >> 7) * DFF + 128 * pn + (w & 127); } else c0 = col0 + n0;
    const int col = c0 + 4 * n4, colc = col < nvalid ? col : nvalid - 4;
    const float* gsrc = gain ? gain : src;
#pragma unroll
    for (int i = 0; i < 4; ++i) {
        const int kk = k0 + kq + 32 * i;
        f32x4 x = *gp((const f32x4*)(src + (size_t)kk * ld + colc));
        if (col >= nvalid) x = (f32x4){0.f, 0.f, 0.f, 0.f};
        const float gl = *gp(gsrc + kk);
        gv[i] = gain ? gl : 1.0f;
        v[i] = x;
    }
}
DI void transpose_job(const Ctx& cx, const float* __restrict__ src, int ld, int K, int Nd, int type, int col0, int nvalid, const float* __restrict__ gain, bf16_t* __restrict__ dst, LAS float* tile, int& tbase, float scale = 1.0f) {
    const int tid = cx.tid;
    const int ntk = K >> 7, nt = ntk * (Nd >> 6);
    const int n4 = tid & 15, kq = tid >> 4;
    const int Tlo = cx.plo > tbase ? cx.plo : tbase, Thi = cx.phi < tbase + nt ? cx.phi : tbase + nt;
    int T = Tlo + ((cx.pq - (Tlo - cx.plo)) % cx.pst + cx.pst) % cx.pst;
    f32x4 cur[4], nxt[4]; float gc[4], gn[4];
    if (T < Thi) transpose_load(src, ld, ntk, type, col0, nvalid, gain, T - tbase, n4, kq, cur, gc);
    for (; T < Thi; T += cx.pst) {
        const int t = T - tbase;
        transpose_load(src, ld, ntk, type, col0, nvalid, gain, (T + cx.pst < Thi) ? t + cx.pst : t, n4, kq, nxt, gn);
        const int tn = t / ntk, tk = t - tn * ntk;
        const int n0 = tn * 64, k0 = tk * 128;
#pragma unroll
        for (int i = 0; i < 4; ++i)
#pragma unroll
            for (int e = 0; e < 4; ++e) tile[(kq + 32 * i) * 65 + 4 * n4 + e] = cur[i][e] * (gc[i] * scale);
        lds_barrier();
#pragma unroll
        for (int i = 0; i < 2; ++i) {
            const int c = tid + 512 * i, n = c & 63, k8 = (c >> 6) * 8;
            float o[8];
#pragma unroll
            for (int j = 0; j < 8; ++j) o[j] = tile[(k8 + j) * 65 + n];
            u32x4 w; w.x = pk2(o[0], o[1]); w.y = pk2(o[2], o[3]); w.z = pk2(o[4], o[5]); w.w = pk2(o[6], o[7]);
            *gpw((u32x4*)(dst + (size_t)(n0 + n) * K + k0 + k8)) = w;
        }
        lds_barrier();
#pragma unroll
        for (int i = 0; i < 4; ++i) { cur[i] = nxt[i]; gc[i] = gn[i]; }
    }
    tbase += nt;
}

DI void prep_w1in(const Ctx& cx, const Params& p, int L, LAS float* tile, int& tb) {
    transpose_job(cx, IN(2) + (size_t)L * DM * NUP, NUP, DM, NUP, 1, 0, NUP, IN(1) + L * DM, (bf16_t*)(p.ws + WS_W1IN), tile, tb);
}
DI void prep_w1out(const Ctx& cx, const Params& p, int L, LAS float* tile, int& tb) {
    transpose_job(cx, IN(3) + (size_t)L * DFF * DM, DM, DFF, DM, 0, 0, DM, nullptr, (bf16_t*)(p.ws + WS_W1OUT), tile, tb);
}
DI void prep_w2(const Ctx& cx, const Params& p, int L, LAS float* tile, int& tb) {
    unsigned char* ws = p.ws;
    transpose_job(cx, IN(6) + (size_t)L * DM * NUP, NUP, DM, NUP, 1, 0, NUP, IN(5) + L * DM, (bf16_t*)(ws + WS_W2IN), tile, tb);
    transpose_job(cx, IN(7) + (size_t)L * DFF * DM, DM, DFF, DM, 0, 0, DM, nullptr, (bf16_t*)(ws + WS_W2OUT), tile, tb);
}
DI void prep_wmix(const Ctx& cx, const Params& p, int L, LAS float* tile, int& tb) {
    unsigned char* ws = p.ws;
    if (L < 2) {
        const float* wq = IN(8) + (size_t)L * DM * 3072;
        transpose_job(cx, wq, 3072, DM, 1024, 0, 0, 3072, IN(4) + L * DM, (bf16_t*)(ws + WS_WMIX), tile, tb, 0.125f * 1.4426950408889634f);
        transpose_job(cx, wq, 3072, DM, 1024, 0, 1024, 3072, IN(4) + L * DM, (bf16_t*)(ws + WS_WMIX) + (size_t)1024 * DM, tile, tb);
        transpose_job(cx, wq, 3072, DM, 1024, 0, 2048, 3072, IN(4) + L * DM, (bf16_t*)(ws + WS_WMIX + 4 * MiB), tile, tb);
        transpose_job(cx, IN(9) + (size_t)L * DM * DM, DM, DM, DM, 0, 0, DM, nullptr, (bf16_t*)(ws + WS_WMIX + 6 * MiB), tile, tb);
    } else {
        transpose_job(cx, IN(19) + (size_t)(L - 2) * DM * 1072, 1072, DM, 1280, 0, 0, 1072, IN(4) + L * DM, (bf16_t*)(ws + WS_WMIX), tile, tb);
        transpose_job(cx, IN(21) + (size_t)(L - 2) * DM * DM, DM, DM, DM, 0, 0, DM, nullptr, (bf16_t*)(ws + WS_WMIX + 6 * MiB), tile, tb);
    }
}
DI void prep_phase(const Ctx& cx, const Params& p, int L, LAS float* tile) {
    int tb = 0;
    unsigned char* ws = p.ws;
    const int tid = cx.tid, gtid = cx.bid * 512 + tid, gsz = cx.nb * 512;
    if (L == 0) {
        float2* rope = (float2*)(ws + WS_ROPE);
        for (int i = gtid; i < SEQ * 8; i += gsz) {
            const int t = i >> 3, f = i & 7;
            const float inv = exp2f(-(float)f * 0.125f * 18.931568569324174f);
            const float ang = (float)t * inv; float rev = ang * 0.15915494309189535f; rev -= floorf(rev);
            rope[i] = make_float2(__builtin_amdgcn_cosf(rev), __builtin_amdgcn_sinf(rev));
        }
        u64* rowss = (u64*)(ws + WS_RP);
        { unsigned z = 0u; asm volatile("" : "+v"(z));
          const u64 zz = ((u64)z << 32) | z;
          for (int i = gtid; i < 12 * MTOK; i += gsz) *gpw(rowss + MTOK + i) = zz; }
        const float* x = IN(0); bf16_t* hb = (bf16_t*)(ws + WS_HB);
        const int lane = tid & 63, gw = gtid >> 6, nw = gsz >> 6;
        for (int row = gw; row < MTOK; row += 4 * nw) {
            f32x4 va[4][4]; int rw[4];
#pragma unroll
            for (int q = 0; q < 4; ++q) {
                rw[q] = (row + q * nw < MTOK) ? row + q * nw : row;
#pragma unroll
                for (int i = 0; i < 4; ++i) va[q][i] = *gp((const f32x4*)(x + (size_t)rw[q] * DM + i * 256 + lane * 4));
            }
#pragma unroll
            for (int q = 0; q < 4; ++q) {
                float ss = 0.f;
#pragma unroll
                for (int i = 0; i < 4; ++i) {
                    const f32x4 v = va[q][i];
                    ss += v[0] * v[0] + v[1] * v[1] + v[2] * v[2] + v[3] * v[3];
                    u32x2 w; w.x = pk2(v[0], v[1]); w.y = pk2(v[2], v[3]); *gpw((u32x2*)(hb + (size_t)rw[q] * DM + i * 256 + lane * 4)) = w;
                }
#pragma unroll
                for (int o = 32; o > 0; o >>= 1) ss += __shfl_xor(ss, o);
                if (lane == 0) *gpw(rowss + rw[q]) = ss_fix(ss);
            }
        }
        bf16_t* kvn_t = (bf16_t*)(ws + WS_WKV); bf16_t* kvT_t = (bf16_t*)(ws + WS_WKV + 2 * MiB);
        const int cn[4] = {0, 256, 512, 1024};
#pragma unroll
        for (int i = 0; i < 4; ++i) transpose_job(cx, IN(11), 1536, 1024, 256, 0, cn[i], 1536, IN(10), kvn_t + (size_t)i * 256 * 1024, tile, tb);
        transpose_job(cx, IN(11), 1536, 1024, 256, 0, 768, 1536, IN(10), kvT_t, tile, tb);
        transpose_job(cx, IN(11), 1536, 1024, 256, 0, 1280, 1536, IN(10), kvT_t + (size_t)256 * 1024, tile, tb);
        transpose_job(cx, IN(15), 256, 2048, 256, 0, 0, 256, nullptr, (bf16_t*)(ws + WS_WKV + 3 * MiB), tile, tb);
        transpose_job(cx, IN(17), 256, 2048, 256, 0, 0, 256, nullptr, (bf16_t*)(ws + WS_WKV + 4 * MiB), tile, tb);
    }
    prep_w1in(cx, p, 0, tile, tb);
}

DI void sb_attn_phase(const Ctx& cx, const Params& p) {
    const bf16_t* qk = (const bf16_t*)(p.ws + WS_S);
    const bf16_t* vt = (const bf16_t*)(p.ws + WS_S + 64 * MiB);
    bf16_t* ao = (bf16_t*)(p.ws + WS_S + 96 * MiB);
    const int lane = cx.tid & 63, wid = cx.tid >> 6, r = lane & 31, h = lane >> 5;
    for (int item = cx.bid; item < 1024; item += cx.nb) {
        const int sblk = item & 255, pair = (item >> 8) * 32 + (sblk & 7) * 4 + (sblk >> 6), qt = (sblk >> 3) & 7;
        const int b = pair >> 4, head = pair & 15;
        const int tok0 = b * SEQ, t0 = qt * 256 + wid * 32;
        bf16x8 qf[4];
#pragma unroll
        for (int s = 0; s < 4; ++s) qf[s] = *gp((const bf16x8*)(qk + (size_t)(tok0 + t0 + r) * 2048 + head * 64 + 16 * s + 8 * h));
        f32x16 o[2];
#pragma unroll
        for (int i = 0; i < 16; ++i) { o[0][i] = 0.f; o[1][i] = 0.f; }
        float carry = 1.0f;
        for (int kt = t0 >> 5; kt >= 0; --kt) {
            const int s0 = kt * 32; const bool diag = (s0 == t0);
            f32x16 x;
#pragma unroll
            for (int i = 0; i < 16; ++i) x[i] = 0.f;
#pragma unroll
            for (int s = 0; s < 4; ++s) {
                const bf16x8 kf = *gp((const bf16x8*)(qk + (size_t)(tok0 + s0 + r) * 2048 + 1024 + head * 64 + 16 * s + 8 * h));
                x = MFMA32(kf, qf[s], x);
            }
            bf16x8 vf[2][2];
#pragma unroll
            for (int db = 0; db < 2; ++db)
#pragma unroll
                for (int s2 = 0; s2 < 2; ++s2) {
                    const bf16_t* vp = vt + (size_t)(head * 64 + 32 * db + r) * MTOK + tok0 + s0 + 16 * s2 + 4 * h;
                    const s16x4 lo = *gp((const s16x4*)vp), hi = *gp((const s16x4*)(vp + 8));
                    vf[db][s2] = __builtin_shufflevector(lo, hi, 0, 1, 2, 3, 4, 5, 6, 7);
                }
            float c[16], bt[16];
#pragma unroll
            for (int i = 0; i < 16; ++i) {
                const float E = fminf(__builtin_amdgcn_exp2f(x[i]), 1e30f);
                c[i] = __builtin_amdgcn_rcpf(1.0f + E);
                bt[i] = E * c[i];
            }
            if (diag) {
#pragma unroll
                for (int i = 0; i < 16; ++i) { const int kl = (i & 3) + 8 * (i >> 2) + 4 * h; const bool past = kl < r; c[i] = past ? c[i] : 1.0f; bt[i] = past ? bt[i] : 0.f; }
            }
            float gp[4], pp[4], T[4];
#pragma unroll
            for (int g = 0; g < 4; ++g) { gp[g] = (c[4 * g] * c[4 * g + 1]) * (c[4 * g + 2] * c[4 * g + 3]); pp[g] = __shfl_xor(gp[g], 32); T[g] = gp[g] * pp[g]; }
            float R[4]; R[3] = 1.0f; R[2] = T[3]; R[1] = T[3] * T[2]; R[0] = R[1] * T[1];
            float w[16];
#pragma unroll
            for (int g = 0; g < 4; ++g) {
                const float A = carry * R[g] * (h == 0 ? pp[g] : 1.0f);
                const float e2 = c[4 * g + 3], e1 = e2 * c[4 * g + 2], e0 = e1 * c[4 * g + 1];
                w[4 * g + 0] = bt[4 * g + 0] * (A * e0);
                w[4 * g + 1] = bt[4 * g + 1] * (A * e1);
                w[4 * g + 2] = bt[4 * g + 2] * (A * e2);
                w[4 * g + 3] = bt[4 * g + 3] * A;
            }
            carry *= (T[0] * T[1]) * (T[2] * T[3]);
#pragma unroll
            for (int s2 = 0; s2 < 2; ++s2) {
                u32x4 pw; pw.x = pk2(w[8 * s2 + 0], w[8 * s2 + 1]); pw.y = pk2(w[8 * s2 + 2], w[8 * s2 + 3]); pw.z = pk2(w[8 * s2 + 4], w[8 * s2 + 5]); pw.w = pk2(w[8 * s2 + 6], w[8 * s2 + 7]);
                const bf16x8 pf = __builtin_bit_cast(bf16x8, pw);
                o[0] = MFMA32(vf[0][s2], pf, o[0]);
                o[1] = MFMA32(vf[1][s2], pf, o[1]);
            }
#ifndef SB_NO_EARLY_EXIT
            if (__all(carry < 1e-37f)) break;
#endif
        }
#pragma unroll
        for (int db = 0; db < 2; ++db)
#pragma unroll
            for (int g = 0; g < 4; ++g) {
                u32x2 w; w.x = pk2(o[db][4 * g], o[db][4 * g + 1]); w.y = pk2(o[db][4 * g + 2], o[db][4 * g + 3]);
                *gpw((u32x2*)(ao + (size_t)(tok0 + t0 + r) * DM + head * 64 + 32 * db + 8 * g + 4 * h)) = w;
            }
    }
}

DI void kv_prep_phase(const Ctx& cx, const Params& p) {
    unsigned char* ws = p.ws;
    bf16_t* kvn = (bf16_t*)(ws + WS_KVN);
    const float2* rope = (const float2*)(ws + WS_ROPE);
    const int gtid = cx.bid * 512 + cx.tid, gsz = cx.nb * 512;
    for (int i = gtid; i < MTOK * 8; i += gsz) {
        const int tok = i >> 3, which = (i >> 2) & 1, g = i & 3;
        bf16_t* ptr = kvn + (size_t)tok * 1024 + (2 + which) * 256 + g * 64;
        const float* gn = IN(12) + (1 + which) * 64;
        u32x4 raw[8]; float v[64];
#pragma unroll
        for (int c = 0; c < 8; ++c) raw[c] = *gp((const u32x4*)(ptr + 8 * c));
        float ss = 0.f;
#pragma unroll
        for (int c = 0; c < 8; ++c)
#pragma unroll
            for (int e = 0; e < 4; ++e) { v[8 * c + 2 * e] = bflo(raw[c][e]); v[8 * c + 2 * e + 1] = bfhi(raw[c][e]); }
#pragma unroll
        for (int d = 0; d < 64; ++d) ss += v[d] * v[d];
        const float rs = rsqrtf(ss * (1.0f / 64.0f) + 1e-6f);
#pragma unroll
        for (int d = 0; d < 64; ++d) v[d] = v[d] * rs * gn[d];
        const int pos = tok & (SEQ - 1);
#pragma unroll
        for (int f = 0; f < 8; ++f) { const float2 cs = rope[pos * 8 + f]; const float x1 = v[f], x2 = v[f + 8]; v[f] = x1 * cs.x - x2 * cs.y; v[f + 8] = x2 * cs.x + x1 * cs.y; }
#pragma unroll
        for (int c = 0; c < 8; ++c) { u32x4 w; w.x = pk2(v[8 * c], v[8 * c + 1]); w.y = pk2(v[8 * c + 2], v[8 * c + 3]); w.z = pk2(v[8 * c + 4], v[8 * c + 5]); w.w = pk2(v[8 * c + 6], v[8 * c + 7]); *(u32x4*)(ptr + 8 * c) = w; }
    }
    for (int i0 = gtid * 4; i0 < 2 * 4096 * 256; i0 += gsz * 4) {
        u32x4 raw[4]; f32x4 pa[4], pb[4];
#pragma unroll
        for (int u = 0; u < 4; ++u) {
            const int i = i0 + u, which = i >> 20, row = (i >> 8) & 4095, ch = i & 255;
            raw[u] = (u32x4){0u, 0u, 0u, 0u}; pa[u] = (f32x4){0.f, 0.f, 0.f, 0.f}; pb[u] = pa[u];
            if (row < 4064) {
                const int g = row & 3, bc = row >> 2, b = bc / 127, c = bc - b * 127, l = ch >> 3, d0 = (ch & 7) * 8;
                raw[u] = *gp((const u32x4*)(kvn + (size_t)(b * SEQ + 16 * c + l) * 1024 + which * 256 + g * 64 + d0));
                const float* pe = (which ? IN(14) : IN(13)) + l * 64 + d0;
                pa[u] = *gp((const f32x4*)pe); pb[u] = *gp((const f32x4*)(pe + 4));
            }
        }
#pragma unroll
        for (int u = 0; u < 4; ++u) {
            const int i = i0 + u, which = i >> 20, row = (i >> 8) & 4095, ch = i & 255;
            bf16_t* dst = (bf16_t*)(ws + WS_CMP + (size_t)which * 16 * MiB) + (size_t)row * 2048 + ch * 8;
            u32x4 w = {0u, 0u, 0u, 0u};
            if (row < 4064) {
                w.x = pk2(bflo(raw[u].x) + pa[u][0], bfhi(raw[u].x) + pa[u][1]); w.y = pk2(bflo(raw[u].y) + pa[u][2], bfhi(raw[u].y) + pa[u][3]);
                w.z = pk2(bflo(raw[u].z) + pb[u][0], bfhi(raw[u].z) + pb[u][1]); w.w = pk2(bflo(raw[u].w) + pb[u][2], bfhi(raw[u].w) + pb[u][3]);
            }
            *gpw((u32x4*)dst) = w;
        }
    }
}

DI void cmp2_phase(const Ctx& cx, const Params& p, LAS unsigned char* lds) {
    unsigned char* ws = p.ws;
    const f32x2* rope = (const f32x2*)(ws + WS_ROPE);
    bf16_t* kc = (bf16_t*)(ws + WS_KC); bf16_t* vct = (bf16_t*)(ws + WS_VCT);
    const int lane = cx.tid & 63, wid = cx.tid >> 6;
    LAS float* w2L = (LAS float*)lds;
    LAS unsigned char* hidL = lds + 65536;
    for (int which = 0; which < 2; ++which) {
        const float* w2 = which ? IN(18) : IN(16);
        for (int grp = cx.bid; grp < 256; grp += cx.nb) {
            __syncthreads();
#pragma unroll
            for (int i = 0; i < 8; ++i) { const int o = (cx.tid + 512 * i) * 4; *(LAS f32x4*)(w2L + o) = *gp((const f32x4*)(w2 + o)); }
            {
                const int rl = cx.tid >> 5, ch = cx.tid & 31, rp = grp * 16 + rl;
                const int g = rp & 3, c = (rp >> 2) & 127, b = rp >> 9;
                u32x4 hv = {0u, 0u, 0u, 0u};
                if (c < 127) hv = *gp((const u32x4*)((const bf16_t*)(ws + WS_CMP + 32 * MiB + (size_t)which * 2 * MiB) + (size_t)((b * 127 + c) * 4 + g) * 256 + ch * 8));
                *(LAS u32x4*)(hidL + rl * 512 + ch * 16) = hv;
            }
            __syncthreads();
            float acc[2] = {0.f, 0.f};
            for (int k = 0; k < 256; k += 4) {
                const u32x2 h0 = *(const LAS u32x2*)(hidL + (2 * wid) * 512 + k * 2), h1 = *(const LAS u32x2*)(hidL + (2 * wid + 1) * 512 + k * 2);
                const float w0 = w2L[(k + 0) * 64 + lane], w1 = w2L[(k + 1) * 64 + lane], w2v = w2L[(k + 2) * 64 + lane], w3 = w2L[(k + 3) * 64 + lane];
                acc[0] += bflo(h0.x) * w0; acc[0] += bfhi(h0.x) * w1; acc[0] += bflo(h0.y) * w2v; acc[0] += bfhi(h0.y) * w3;
                acc[1] += bflo(h1.x) * w0; acc[1] += bfhi(h1.x) * w1; acc[1] += bflo(h1.y) * w2v; acc[1] += bfhi(h1.y) * w3;
            }
#pragma unroll
            for (int rr = 0; rr < 2; ++rr) {
                const int rp = grp * 16 + 2 * wid + rr;
                const int g = rp & 3, c = (rp >> 2) & 127, b = rp >> 9, bg = b * 4 + g;
                const float a = acc[rr];
                if (which == 0) {
                    float ss = a * a;
#pragma unroll
                    for (int o = 32; o > 0; o >>= 1) ss += __shfl_xor(ss, o);
                    float v = a * rsqrtf(ss * (1.0f / 64.0f) + 1e-6f) * *gp(IN(12) + lane);
                    const float other = __shfl_xor(v, 8);
                    if (lane < 16 && c < 127) { const f32x2 cs = *gp(rope + (16 * c + 31) * 8 + (lane & 7)); v = (lane < 8) ? (v * cs[0] - other * cs[1]) : (v * cs[0] + other * cs[1]); }
                    *gpw(kc + (size_t)(bg * 128 + c) * 64 + lane) = (bf16_t)(pk2(c < 127 ? v : 0.f, 0.f) & 0xffffu);
                } else {
                    *gpw(vct + (size_t)(bg * 64 + lane) * 128 + c) = (bf16_t)(pk2(c < 127 ? a : 0.f, 0.f) & 0xffffu);
                }
            }
        }
    }
}

constexpr int NSA_SB_OFF = 16384, NSA_SB_BYTES = 17920, NSA_V_OFF = 9216;
DI void nsa_stage_load(const bf16_t* __restrict__ kbase, const bf16_t* __restrict__ vtbase, int tok0, int j, int tid, u32x4& kr, u32x4& vr) {
    const int row = tid >> 3, ch = tid & 7;
    kr = *gp((const u32x4*)(kbase + (size_t)(tok0 + 64 * j + row) * 1024 + ch * 8));
    vr = *gp((const u32x4*)(vtbase + (size_t)row * MTOK + tok0 + 64 * j + ch * 8));
}
DI void nsa_stage_write(LAS unsigned char* sb, int tid, const u32x4& kr, const u32x4& vr) {
    const int row = tid >> 3, ch = tid & 7;
    *(LAS u32x4*)(sb + row * 144 + ch * 16) = kr;
    LAS u32x2* vp = (LAS u32x2*)(sb + NSA_V_OFF + row * 136 + ch * 16);
    u32x2 a; a.x = vr.x; a.y = vr.y; u32x2 b; b.x = vr.z; b.y = vr.w;
    vp[0] = a; vp[1] = b;
}
DI void nsa_step(const bool EDGE, const LAS unsigned char* sb, int key0, float xinit, int lo, int hi, const bf16x8 (&qf)[4], f32x16 (&o)[2], float& lrun, int r, int h) {
    f32x16 x0, x1;
#pragma unroll
    for (int i = 0; i < 16; ++i) { x0[i] = xinit; x1[i] = xinit; }
#pragma unroll
    for (int s = 0; s < 4; ++s) {
        const bf16x8 k0 = *(const LAS bf16x8*)(sb + r * 144 + (16 * s + 8 * h) * 2);
        const bf16x8 k1 = *(const LAS bf16x8*)(sb + (32 + r) * 144 + (16 * s + 8 * h) * 2);
        x0 = MFMA32(k0, qf[s], x0);
        x1 = MFMA32(k1, qf[s], x1);
    }
    if (EDGE) {
#pragma unroll
        for (int i = 0; i < 16; ++i) {
            const int key = key0 + (i & 3) + 8 * (i >> 2) + 4 * h;
            x0[i] = (key >= lo && key <= hi) ? x0[i] : -1e30f;
            x1[i] = (key + 32 >= lo && key + 32 <= hi) ? x1[i] : -1e30f;
        }
    }
    float ls = 0.f;
#pragma unroll
    for (int i = 0; i < 16; ++i) { x0[i] = __builtin_amdgcn_exp2f(x0[i]); x1[i] = __builtin_amdgcn_exp2f(x1[i]); ls += x0[i] + x1[i]; }
    lrun += ls;
#pragma unroll
    for (int s2 = 0; s2 < 4; ++s2) {
        u32x4 pw;
        if (s2 < 2) { pw.x = pk2(x0[8 * s2 + 0], x0[8 * s2 + 1]); pw.y = pk2(x0[8 * s2 + 2], x0[8 * s2 + 3]); pw.z = pk2(x0[8 * s2 + 4], x0[8 * s2 + 5]); pw.w = pk2(x0[8 * s2 + 6], x0[8 * s2 + 7]); }
        else { const int q = s2 - 2; pw.x = pk2(x1[8 * q + 0], x1[8 * q + 1]); pw.y = pk2(x1[8 * q + 2], x1[8 * q + 3]); pw.z = pk2(x1[8 * q + 4], x1[8 * q + 5]); pw.w = pk2(x1[8 * q + 6], x1[8 * q + 7]); }
        const bf16x8 pf = __builtin_bit_cast(bf16x8, pw);
#pragma unroll
        for (int db = 0; db < 2; ++db) {
            const LAS unsigned char* vp = sb + NSA_V_OFF + (32 * db + r) * 136 + (16 * s2 + 4 * h) * 2;
            const s16x4 lo8 = *(const LAS s16x4*)vp, hi8 = *(const LAS s16x4*)(vp + 16);
            o[db] = MFMA32(__builtin_shufflevector(lo8, hi8, 0, 1, 2, 3, 4, 5, 6, 7), pf, o[db]);
        }
    }
}
DI int pop_bit(unsigned& rem) { if (!rem) return -1; const int j = __builtin_ctz(rem); rem &= rem - 1u; return j; }
DI void nsa_branch(const Ctx& cx, LAS unsigned char* lds, int& buf, const bf16_t* __restrict__ kbase, const bf16_t* __restrict__ vtbase, int tok0, int qt, int jedge2, int lo, int t,
                   unsigned selmask, unsigned wavemask, unsigned blockmask, const bf16x8 (&qf)[4], f32x16 (&o)[2], float shift, float& lrun, int r, int h) {
    unsigned rem = blockmask;
    int ja = pop_bit(rem), jb = pop_bit(rem);
    u32x4 kA, vA, kB, vB;
    nsa_stage_load(kbase, vtbase, tok0, ja, cx.tid, kA, vA);
    nsa_stage_load(kbase, vtbase, tok0, jb >= 0 ? jb : 0, cx.tid, kB, vB);
    for (;;) {
        {
            LAS unsigned char* sb = lds + NSA_SB_OFF + buf * NSA_SB_BYTES;
            nsa_stage_write(sb, cx.tid, kA, vA);
            lds_barrier();
            const int j = ja; ja = pop_bit(rem);
            nsa_stage_load(kbase, vtbase, tok0, ja >= 0 ? ja : 0, cx.tid, kA, vA);
            if ((wavemask >> j) & 1u) nsa_step((j == qt) || (j == jedge2), sb, 64 * j, ((selmask >> j) & 1u) ? shift : -1e30f, lo, t, qf, o, lrun, r, h);
            buf ^= 1;
        }
        if (jb < 0) break;
        {
            LAS unsigned char* sb = lds + NSA_SB_OFF + buf * NSA_SB_BYTES;
            nsa_stage_write(sb, cx.tid, kB, vB);
            lds_barrier();
            const int j = jb; jb = pop_bit(rem);
            nsa_stage_load(kbase, vtbase, tok0, jb >= 0 ? jb : 0, cx.tid, kB, vB);
            if ((wavemask >> j) & 1u) nsa_step((j == qt) || (j == jedge2), sb, 64 * j, ((selmask >> j) & 1u) ? shift : -1e30f, lo, t, qf, o, lrun, r, h);
            buf ^= 1;
        }
        if (ja < 0) break;
    }
}

DI float sel_score(float imp, int j, int cur) { const bool forced = (j == 0) || (j == cur) || (j == cur - 1); return forced ? 1e4f : (j <= cur ? imp : -1e4f); }

DI void nsa_attn_phase(const Ctx& cx, const Params& p, int li, LAS unsigned char* lds, float* ldsf) {
    unsigned char* ws = p.ws;
    const bf16_t* qg = (const bf16_t*)(ws + WS_S);
    bf16_t* ao = (bf16_t*)(ws + WS_S + 96 * MiB);
    const bf16_t* kvn = (const bf16_t*)(ws + WS_KVN); const bf16_t* kvT = (const bf16_t*)(ws + WS_KVT);
    const bf16_t* kc = (const bf16_t*)(ws + WS_KC); const bf16_t* vct = (const bf16_t*)(ws + WS_VCT);
    const float2* rope = (const float2*)(ws + WS_ROPE);
    const int lane = cx.tid & 63, wid = cx.tid >> 6, r = lane & 31, h = lane >> 5;
    LAS float* impL = (LAS float*)lds + wid * 256;
    LAS unsigned* selL = (LAS unsigned*)(lds + 8192) + wid * 8;
    float gmax1, gmax2;
    float gmax0;
    { float a0 = fabsf(*gp(IN(12) + lane));
#pragma unroll
      for (int o = 32; o > 0; o >>= 1) a0 = fmaxf(a0, __shfl_xor(a0, o));
      gmax0 = a0; }
    { float a1 = fabsf(IN(12)[64 + lane]), a2 = fabsf(IN(12)[128 + lane]);
#pragma unroll
      for (int o = 32; o > 0; o >>= 1) { a1 = fmaxf(a1, __shfl_xor(a1, o)); a2 = fmaxf(a2, __shfl_xor(a2, o)); }
      gmax1 = a1; gmax2 = a2; }
    int buf = 0, staged_bg = -1;
    constexpr int KC_OFF = 53248, VC_OFF = 71680, QN_OFF = 8704;
    const LAS float* qnL = (const LAS float*)(lds + QN_OFF);
    for (int e = cx.bid; e < 1024; e += cx.nb) {
        const int k4 = e >> 8, blk = e & 255, bg = (blk & 7) * 4 + (blk >> 6), u = (blk >> 3) & 7;
        const int qt = (k4 == 0) ? u : (k4 == 1) ? 15 - u : (k4 == 2) ? 16 + u : 31 - u;
        const int b = bg >> 2, g = bg & 3, tok0 = b * SEQ;
        const int ql = r >> 2, rr = r & 3, t = 64 * qt + 8 * wid + ql, head = 4 * g + rr;
        const size_t token = (size_t)(tok0 + t);
        if (bg != staged_bg) {
            __syncthreads();
#pragma unroll
            for (int i = 0; i < 2; ++i) {
                const int c = cx.tid + 512 * i;
                { const int row = c >> 3, ch = c & 7; *(LAS u32x4*)(lds + KC_OFF + row * 144 + ch * 16) = *gp((const u32x4*)(kc + (size_t)(bg * 128 + row) * 64 + ch * 8)); }
                { const int row = c >> 4, ch = c & 15; const u32x4 v = *gp((const u32x4*)(vct + (size_t)(bg * 64 + row) * 128 + ch * 8));
                  LAS u32x2* vp = (LAS u32x2*)(lds + VC_OFF + row * 264 + ch * 16); u32x2 a; a.x = v.x; a.y = v.y; u32x2 b2; b2.x = v.z; b2.y = v.w; vp[0] = a; vp[1] = b2; }
            }
            if (cx.tid < 64) ((LAS float*)(lds + QN_OFF))[cx.tid] = *gp(IN(20) + li * 64 + cx.tid);
            staged_bg = bg;
            __syncthreads();
        }
        bf16x8 qf[4]; float qn2 = 0.f;
        {
            float v[4][8]; float ss = 0.f;
#pragma unroll
            for (int s = 0; s < 4; ++s) {
                const u32x4 raw = *gp((const u32x4*)(qg + token * 1280 + head * 64 + 16 * s + 8 * h));
#pragma unroll
                for (int q = 0; q < 4; ++q) { v[s][2 * q] = bflo(raw[q]); v[s][2 * q + 1] = bfhi(raw[q]); }
#pragma unroll
                for (int j = 0; j < 8; ++j) ss += v[s][j] * v[s][j];
            }
            ss += __shfl_xor(ss, 32);
            const float rs = rsqrtf(ss * (1.0f / 64.0f) + 1e-6f);
#pragma unroll
            for (int s = 0; s < 4; ++s)
                { const f32x4 g0 = *(const LAS f32x4*)(qnL + 16 * s + 8 * h), g1 = *(const LAS f32x4*)(qnL + 16 * s + 8 * h + 4);
#pragma unroll
                  for (int j = 0; j < 4; ++j) { v[s][j] = v[s][j] * rs * g0[j]; v[s][4 + j] = v[s][4 + j] * rs * g1[j]; } }
#pragma unroll
            for (int j = 0; j < 8; ++j) {
                const f32x4 cs4 = *gp((const f32x4*)rope + t * 4 + (j >> 1)); const float2 cs = (j & 1) ? make_float2(cs4[2], cs4[3]) : make_float2(cs4[0], cs4[1]); const float pb = __shfl_xor(v[0][j], 32);
                v[0][j] = v[0][j] * cs.x + (h ? pb : -pb) * cs.y;
            }
#pragma unroll
            for (int s = 0; s < 4; ++s) { u32x4 w; const float qs = 0.125f * 1.4426950408889634f;
#pragma unroll
                for (int j = 0; j < 8; ++j) qn2 += (v[s][j] * qs) * (v[s][j] * qs);
                w.x = pk2(v[s][0] * qs, v[s][1] * qs); w.y = pk2(v[s][2] * qs, v[s][3] * qs); w.z = pk2(v[s][4] * qs, v[s][5] * qs); w.w = pk2(v[s][6] * qs, v[s][7] * qs); qf[s] = __builtin_bit_cast(bf16x8, w); }
        }
        qn2 += __shfl_xor(qn2, 32);
        const float qnorm = sqrtf(qn2);
        float gate[3];
#pragma unroll
        for (int br = 0; br < 3; ++br) { const float gl = bf2f(*gp(qg + token * 1280 + 1024 + br * 16 + g * 4 + rr)); gate[br] = __builtin_amdgcn_rcpf(1.0f + __expf(-gl)); }
        f32x16 fin[2];
        {
            const int nvalid = (t >= 31) ? (((t - 31) >> 4) + 1) : 0;
            f32x16 xc[4];
            const float cshift = -fminf(1.01f * qnorm * 8.0f * gmax0, 60.0f);
#pragma unroll
            for (int T = 0; T < 4; ++T) {
#pragma unroll
                for (int i = 0; i < 16; ++i) xc[T][i] = cshift;
#pragma unroll
                for (int s = 0; s < 4; ++s) {
                    const bf16x8 kf = *(const LAS bf16x8*)(lds + KC_OFF + (32 * T + r) * 144 + (16 * s + 8 * h) * 2);
                    xc[T] = MFMA32(kf, qf[s], xc[T]);
                }
            }
            float ls = 0.f;
            const int nvh = nvalid - 4 * h;
#pragma unroll
            for (int T = 0; T < 4; ++T)
#pragma unroll
                for (int i = 0; i < 16; ++i) { const float pv = (32 * T + (i & 3) + 8 * (i >> 2) < nvh) ? __builtin_amdgcn_exp2f(xc[T][i]) : 0.f; xc[T][i] = pv; ls += pv; }
            ls += __shfl_xor(ls, 32);
            const float inv = (nvalid > 0) ? 1.0f / ls : 0.f;
#pragma unroll
            for (int T = 0; T < 4; ++T)
#pragma unroll
                for (int i = 0; i < 16; ++i) xc[T][i] *= inv;
#pragma unroll
            for (int i = 0; i < 16; ++i) { fin[0][i] = 0.f; fin[1][i] = 0.f; }
#pragma unroll
            for (int T = 0; T < 4; ++T)
#pragma unroll
                for (int s2 = 0; s2 < 2; ++s2) {
                    u32x4 pw; pw.x = pk2(xc[T][8 * s2 + 0], xc[T][8 * s2 + 1]); pw.y = pk2(xc[T][8 * s2 + 2], xc[T][8 * s2 + 3]); pw.z = pk2(xc[T][8 * s2 + 4], xc[T][8 * s2 + 5]); pw.w = pk2(xc[T][8 * s2 + 6], xc[T][8 * s2 + 7]);
                    const bf16x8 pf = __builtin_bit_cast(bf16x8, pw);
#pragma unroll
                    for (int db = 0; db < 2; ++db) {
                        const LAS unsigned char* vp = lds + VC_OFF + (32 * db + r) * 264 + (32 * T + 16 * s2 + 4 * h) * 2;
                        const s16x4 lo = *(const LAS s16x4*)vp, hi = *(const LAS s16x4*)(vp + 16);
                        fin[db] = MFMA32(__builtin_shufflevector(lo, hi, 0, 1, 2, 3, 4, 5, 6, 7), pf, fin[db]);
                    }
                }
#pragma unroll
            for (int i = 0; i < 16; ++i) { fin[0][i] *= gate[0]; fin[1][i] *= gate[0]; }
            float pe[4][4];
#pragma unroll
            for (int T = 0; T < 4; ++T)
#pragma unroll
                for (int gq = 0; gq < 4; ++gq) pe[T][gq] = __shfl_xor(xc[T][4 * gq + 3], 32);
#pragma unroll
            for (int T = 0; T < 4; ++T)
#pragma unroll
                for (int gq = 0; gq < 4; ++gq) {
                    float extra;
                    if (h) extra = pe[T][gq];
                    else extra = (gq > 0) ? pe[T][gq - 1] : (T > 0 ? pe[T > 0 ? T - 1 : 0][3] : 0.f);
                    float im = (xc[T][4 * gq] + xc[T][4 * gq + 1]) + (xc[T][4 * gq + 2] + xc[T][4 * gq + 3]) + extra;
                    im += __shfl_xor(im, 1); im += __shfl_xor(im, 2);
                    if (rr == 0) { const int jsel = 8 * T + 2 * gq + h; impL[ql * 32 + jsel] = sel_score(im, jsel, qt); }
                }
        }
        __syncthreads();
        {
#pragma unroll 1
            for (int pass = 0; pass < 4; ++pass) {
                const int q2 = 2 * pass + h, jj = r;
                const float sc = impL[q2 * 32 + jj];
                const LAS f32x4* row = (const LAS f32x4*)(impL + q2 * 32);
                int rank = 0;
#pragma unroll
                for (int c4 = 0; c4 < 8; ++c4) {
                    const f32x4 v4 = row[c4];
#pragma unroll
                    for (int e4 = 0; e4 < 4; ++e4) { const int j2 = 4 * c4 + e4; rank += ((v4[e4] > sc) || (v4[e4] == sc && j2 < jj)) ? 1 : 0; }
                }
                const unsigned long long bal = __ballot(rank < 8);
                if (r == 0) selL[q2] = h ? (unsigned)(bal >> 32) : (unsigned)bal;
            }
        }
        __syncthreads();
        const unsigned qmask = (qt >= 31) ? 0xffffffffu : ((2u << qt) - 1u);
        const unsigned selmask = selL[ql] & qmask;
        unsigned wavemask = selmask;
#pragma unroll
        for (int o = 4; o < 32; o <<= 1) wavemask |= __shfl_xor(wavemask, o);
        unsigned blockmask = ((const LAS unsigned*)(lds + 8192))[lane] & qmask;
#pragma unroll
        for (int o = 1; o < 64; o <<= 1) blockmask |= __shfl_xor(blockmask, o);
        blockmask = __builtin_amdgcn_readfirstlane(blockmask);
#pragma unroll 1
        for (int br = 1; br <= 2; ++br) {
            f32x16 o[2];
#pragma unroll
            for (int i = 0; i < 16; ++i) { o[0][i] = 0.f; o[1][i] = 0.f; }
            float lrun = 0.f;
            const float shift = -fminf(1.01f * qnorm * 8.0f * (br == 1 ? gmax1 : gmax2), 60.0f);
            const int jlo = (br == 2 && qt > 8) ? qt - 8 : 0;
            const unsigned wmask = qmask & ~((1u << jlo) - 1u);
            const bf16_t* kb = kvn + (br == 1 ? 512 : 768) + g * 64;
            const bf16_t* vb = kvT + (size_t)((br == 1 ? 0 : 256) + g * 64) * MTOK;
            nsa_branch(cx, lds, buf, kb, vb, tok0, qt, (br == 2) ? qt - 8 : -100, (br == 2) ? t - 511 : -(1 << 30), t,
                       (br == 1) ? selmask : 0xffffffffu, (br == 1) ? wavemask : wmask, (br == 1) ? blockmask : wmask, qf, o, shift, lrun, r, h);
            lrun += __shfl_xor(lrun, 32);
            const float sc = ((br == 1) ? gate[1] : gate[2]) / lrun;
#pragma unroll
            for (int i = 0; i < 16; ++i) { fin[0][i] += o[0][i] * sc; fin[1][i] += o[1][i] * sc; }
        }
#pragma unroll
        for (int db = 0; db < 2; ++db)
#pragma unroll
            for (int gq = 0; gq < 4; ++gq) {
                u32x2 w; w.x = pk2(fin[db][4 * gq], fin[db][4 * gq + 1]); w.y = pk2(fin[db][4 * gq + 2], fin[db][4 * gq + 3]);
                *gpw((u32x2*)(ao + token * DM + head * 64 + 32 * db + 8 * gq + 4 * h)) = w;
            }
    }
}


#define XB_TMO      128
#define XB_XCNT(j)  (256  + 64 * (j))
#define XB_XSUB(j)  (1280 + 64 * (j))
#define XB_XGEN(j)  (2304 + 64 * (j))
#define XB_TOP      3328
#define XB_TOPGEN   3392
#define XCD_BAR_WORDS 3456
#define XB_SPIN_CAP (1u << 18)
DI unsigned xb_ld(unsigned* p)              { return __hip_atomic_load(p, __ATOMIC_RELAXED, __HIP_MEMORY_SCOPE_AGENT); }
DI unsigned xb_add(unsigned* p, unsigned v) { return __hip_atomic_fetch_add(p, v, __ATOMIC_RELAXED, __HIP_MEMORY_SCOPE_AGENT); }
DI unsigned xb_xcc_id() { return (unsigned)__builtin_amdgcn_s_getreg((3 << 11) | 20) & 0xFu; }
#define XB_SPIN(cond, bar) do { unsigned _sp = 0; while (cond) { __builtin_amdgcn_s_sleep(1); \
    if ((++_sp & 255u) == 0u) { if (xb_ld(&(bar)[XB_TMO])) break; if (_sp > XB_SPIN_CAP) { atomicAdd(&(bar)[XB_TMO], 1u); break; } } } } while (0)
struct XcdBarrier { unsigned* bar; unsigned x; volatile LAS unsigned* st; };
DI XcdBarrier xcd_barrier_post(unsigned* bar, volatile LAS unsigned* st) {
    XcdBarrier b; b.bar = bar; b.x = xb_xcc_id(); b.st = st;
    if (threadIdx.x == 0) (void)xb_add(&bar[XB_XCNT(b.x)], 1u);
    return b;
}
DI void xcd_barrier_complete(unsigned* bar, unsigned x, unsigned& nloc, unsigned& nx) {
    const unsigned G = gridDim.x * gridDim.y * gridDim.z;
    unsigned sum, cnt, mine, sp = 0u;
    for (;;) {
        sum = 0u; cnt = 0u; mine = 0u;
#pragma unroll
        for (unsigned j = 0; j < 16; ++j) { const unsigned c = xb_ld(&bar[XB_XCNT(j)]); sum += c; cnt += (c > 0u) ? 1u : 0u; mine = (j == x) ? c : mine; }
        if (sum == G) break;
        __builtin_amdgcn_s_sleep(1);
        if ((++sp & 255u) == 0u) { if (xb_ld(&bar[XB_TMO])) break; if (sp > XB_SPIN_CAP) { atomicAdd(&bar[XB_TMO], 1u); break; } }
    }
    nloc = mine > 0u ? mine : 1u; nx = cnt > 0u ? cnt : 1u;
}
DI void xcd_barrier(const XcdBarrier& b) {
    asm volatile("s_waitcnt vmcnt(0)" ::: "memory");
    __syncthreads();
    if (threadIdx.x == 0) {
        unsigned* bar = b.bar;
        __builtin_amdgcn_s_waitcnt(0);
        unsigned nloc = b.st[0], nx = b.st[1];
        if (nloc == 0u) { xcd_barrier_complete(bar, b.x, nloc, nx); b.st[0] = nloc; b.st[1] = nx; }
        const unsigned old = xb_add(&bar[XB_XSUB(b.x)], 1u);
        const unsigned gen = old / nloc;
        if (old + 1u == (gen + 1u) * nloc) {
            __builtin_amdgcn_fence(__ATOMIC_RELEASE, "agent");
            asm volatile("s_waitcnt vmcnt(0)" ::: "memory");
            const unsigned og = xb_add(&bar[XB_TOP], 1u);
            const unsigned tg = og / nx;
            if (og + 1u == (tg + 1u) * nx) xb_add(&bar[XB_TOPGEN], 1u);
            else XB_SPIN(xb_ld(&bar[XB_TOPGEN]) == tg, bar);
            __builtin_amdgcn_fence(__ATOMIC_ACQUIRE, "agent");
            xb_add(&bar[XB_XGEN(b.x)], 1u);
            asm volatile("s_waitcnt vmcnt(0)" ::: "memory");
        } else {
            XB_SPIN(xb_ld(&bar[XB_XGEN(b.x)]) == gen, bar);
            __builtin_amdgcn_fence(__ATOMIC_ACQUIRE, "agent");
            asm volatile("s_waitcnt vmcnt(0)" ::: "memory");
        }
    }
    __syncthreads();
}

struct GJob { const bf16_t* A; const bf16_t* Bt; int M, N, K, mode, coff; const u64* rowss; bf16_t* ob; int ldo; const float* hsrc; float* hdst; bf16_t* hb; u64* rowss_out; float alpha; };
DI bool get_job(const Ctx& cx, const Params& p, int L, int k, int i, GJob& J) {
    unsigned char* ws = p.ws;
    u64* rowss = (u64*)(ws + WS_RP);
    float* hbuf = (float*)(ws + WS_H);
    bf16_t* hb = (bf16_t*)(ws + WS_HB);
    bf16_t* S0 = (bf16_t*)(ws + WS_S);
    J.coff = 0; J.rowss = nullptr; J.ob = nullptr; J.ldo = 0; J.hsrc = nullptr; J.hdst = nullptr; J.hb = nullptr; J.rowss_out = nullptr; J.alpha = 0.f;
    if (k == 1 || k == 6) {
        if (i == 0) {
            J.mode = pg8::EP_U; J.A = hb; J.Bt = (const bf16_t*)(ws + (k == 1 ? WS_W1IN : WS_W2IN)); J.M = MTOK; J.N = NUP; J.K = DM;
            J.rowss = rowss + (size_t)(k == 1 ? 3 * L : 3 * L + 2) * MTOK; J.ob = S0; J.ldo = DFF; return true;
        }
        if (L == 2 && k == 1 && i == 1) {
            J.mode = pg8::EP_SCALE; J.A = hb; J.Bt = (const bf16_t*)(ws + WS_WKV); J.M = MTOK; J.N = 1024; J.K = DM; J.rowss = rowss + 6 * MTOK; J.ob = (bf16_t*)(ws + WS_KVN); J.ldo = 1024; return true;
        }
        if (L == 2 && k == 1 && i == 2) {
            J.mode = pg8::EP_SCALET; J.A = (const bf16_t*)(ws + WS_WKV + 2 * MiB); J.Bt = hb; J.M = 512; J.N = MTOK; J.K = DM; J.rowss = rowss + 6 * MTOK; J.ob = (bf16_t*)(ws + WS_KVT); J.ldo = MTOK; J.coff = cx.nb >> 1; return true;
        }
        return false;
    }
    if (k == 2 || k == 7 || k == 5) {
        if (i != 0) return false;
        const bool first = (L == 0 && k == 2), lastp = (L == 3 && k == 7);
        J.mode = pg8::EP_RES; J.M = MTOK; J.N = DM;
        J.hsrc = first ? IN(0) : nullptr; J.hdst = lastp ? p.out : nullptr; J.hb = hb;
        J.rowss_out = lastp ? nullptr : rowss + (size_t)(3 * L + (k == 2 ? 1 : k == 5 ? 2 : 3)) * MTOK; J.alpha = (k == 5) ? 1.0f : 0.5f;
        if (k == 5) { J.A = (const bf16_t*)(ws + WS_S + 96 * MiB); J.Bt = (const bf16_t*)(ws + WS_WMIX + 6 * MiB); J.K = DM; }
        else { J.A = S0; J.Bt = (const bf16_t*)(ws + (k == 2 ? WS_W1OUT : WS_W2OUT)); J.K = DFF; }
        return true;
    }
    if (k == 3) {
        if (L < 2) {
            if (i == 0) { J.mode = pg8::EP_SCALE; J.A = hb; J.Bt = (const bf16_t*)(ws + WS_WMIX); J.M = MTOK; J.N = 2048; J.K = DM; J.rowss = rowss + (size_t)(3 * L + 1) * MTOK; J.ob = S0; J.ldo = 2048; return true; }
            if (i == 1) { J.mode = pg8::EP_SCALET; J.A = (const bf16_t*)(ws + WS_WMIX + 4 * MiB); J.Bt = hb; J.M = 1024; J.N = MTOK; J.K = DM; J.rowss = rowss + (size_t)(3 * L + 1) * MTOK; J.ob = (bf16_t*)(ws + WS_S + 64 * MiB); J.ldo = MTOK; return true; }
            return false;
        }
        if (i == 0) { J.mode = pg8::EP_SCALE; J.A = hb; J.Bt = (const bf16_t*)(ws + WS_WMIX); J.M = MTOK; J.N = 1280; J.K = DM; J.rowss = rowss + (size_t)(3 * L + 1) * MTOK; J.ob = S0; J.ldo = 1280; return true; }
        if (L == 2 && (i == 1 || i == 2)) {
            J.mode = pg8::EP_SILU; J.A = (const bf16_t*)(ws + WS_CMP + (size_t)(i - 1) * 16 * MiB); J.Bt = (const bf16_t*)(ws + WS_WKV + (size_t)(2 + i) * MiB); J.M = 4096; J.N = 256; J.K = 2048;
            J.ob = (bf16_t*)(ws + WS_CMP + 32 * MiB + (size_t)(i - 1) * 2 * MiB); J.ldo = 256; J.coff = cx.nb - (i == 1 ? 64 : 80); return true;
        }
        return false;
    }
    return false;
}

namespace pg8 {
DI void epi_resolve(const EpiKey& key, EpiFields& f) {
    Params p; p.ws = launder_ptr(key.ws); p.out = key.out; p.in[0] = key.x;
    Ctx cx; cx.tid = 0; cx.bid = 0; cx.nb = key.nb; cx.plo = 0; cx.phi = 0x7fffffff; cx.pq = 0; cx.pst = key.nb;
    GJob J; (void)get_job(cx, p, key.L, key.k, key.i, J);
    f.rowss = J.rowss; f.ob = J.ob; f.ldo = J.ldo; f.hsrc = J.hsrc; f.hdst = J.hdst; f.hb = J.hb; f.hlo = (void*)(key.ws + WS_H); f.rowss_out = J.rowss_out; f.alpha = J.alpha;
}
}
DI void run_phase(const Ctx& cx, const Params& p, int ph, LAS unsigned char* lds, float* ldsf) {
    int L, k;
    if (ph < 8) { L = 0; k = ph; }
    else if (ph < 15) { L = 1; k = ph - 7; }
    else if (ph < 23) { L = 2; const int i = ph - 15; k = (i < 3) ? i + 1 : (i == 3 ? 8 : i); }
    else { L = 3; k = ph - 22; }
    if (k == 0) { prep_phase(cx, p, L, (LAS float*)lds); return; }
    if (k == 4) { if (L < 2) sb_attn_phase(cx, p); else nsa_attn_phase(cx, p, L - 2, lds, ldsf); return; }
    if (k == 8) { cmp2_phase(cx, p, lds); return; }
    if (k == 1 || (k == 6 && L < 3)) {
        Ctx cv = cx;
        const int nrem = (MTOK / 256) * (NUP / 256) % cx.nb;
        if (cx.nb == 256 && nrem == 128 && !(L == 2 && k == 1)) {
            const int NT = (k == 1) ? (1408 + (L == 0 ? 512 : 0)) : (704 + (L + 1 < 2 ? 512 : 288));
            const int g = cx.bid >> 6;
            const int b0 = 0, b1 = 0, b2 = (NT * 6) / 100, b3 = (NT * 50) / 100, b4 = 0x7fffffff;
            cv.plo = (g == 0) ? b0 : (g == 1) ? b1 : (g == 2) ? b2 : b3;
            cv.phi = (g == 0) ? b1 : (g == 1) ? b2 : (g == 2) ? b3 : b4;
            cv.pq = cx.bid & 63; cv.pst = 64;
        }
        int tb = 0;
        if (k == 1) { prep_w1out(cv, p, L, (LAS float*)lds, tb); if (L == 0) prep_wmix(cv, p, 0, (LAS float*)lds, tb); if (L != 2) prep_w2(cv, p, L, (LAS float*)lds, tb); }
        else { prep_w1in(cv, p, L + 1, (LAS float*)lds, tb); prep_wmix(cv, p, L + 1, (LAS float*)lds, tb); }
        __syncthreads();
    }
#pragma unroll 1
    for (int i = 0; i < 3; ++i) {
        GJob J;
        if (!get_job(cx, p, L, k, i, J)) break;
        pg8::Gemm g; g.A = J.A; g.Bt = J.Bt; g.M = J.M; g.N = J.N; g.K = J.K;
        pg8::StaticOrder S; S.init(J.M, J.N, cx.nb, (cx.bid + J.coff) % cx.nb);
        pg8::EpiKey key; key.ws = p.ws; key.out = p.out; key.x = p.in[0]; key.L = L; key.k = k; key.i = i; key.nb = cx.nb;
        switch (J.mode) {
        case pg8::EP_U: { pg8::Epi<pg8::EP_U> E; E.key = key; pg8::gemm_phase(cx, lds, g, S, E, J.rowss); } break;
        case pg8::EP_RES: { pg8::Epi<pg8::EP_RES> E; E.key = key; pg8::gemm_phase(cx, lds, g, S, E); } break;
        case pg8::EP_SCALE: { pg8::Epi<pg8::EP_SCALE> E; E.key = key; pg8::gemm_phase(cx, lds, g, S, E, J.rowss); } break;
        case pg8::EP_SCALET: { pg8::Epi<pg8::EP_SCALET> E; E.key = key; pg8::gemm_phase(cx, lds, g, S, E); } break;
        default: { pg8::Epi<pg8::EP_SILU> E; E.key = key; pg8::gemm_phase(cx, lds, g, S, E); } break;
        }
    }
    if (L == 2 && k == 2) kv_prep_phase(cx, p);
    if (L == 2 && k == 3 && cx.nb > 96 && cx.bid >= 96) {
        Ctx cv = cx; cv.plo = 0; cv.phi = 0x7fffffff; cv.pq = cx.bid - 96; cv.pst = cx.nb - 96;
        int tb = 0; __syncthreads();
        prep_w2(cv, p, 2, (LAS float*)lds, tb);
    } else if (L == 2 && k == 3 && cx.nb <= 96) { int tb = 0; __syncthreads(); prep_w2(cx, p, 2, (LAS float*)lds, tb); }
}

__global__ void __launch_bounds__(512, 2) mk_fwd(Params p, int ph_lo, int ph_hi) {
    extern __shared__ __attribute__((aligned(16))) unsigned char shm[];
    LAS unsigned char* lds = (LAS unsigned char*)shm;
    float* ldsf = (float*)shm;
    if (threadIdx.x < 4) ((volatile LAS unsigned*)(lds + LDS_STAGE))[threadIdx.x] = 0u;
    __syncthreads();
    const unsigned xb_x = __builtin_amdgcn_readfirstlane(xcd_barrier_post((unsigned*)(p.ws + WS_BAR), (volatile LAS unsigned*)(lds + LDS_STAGE)).x);
    if (ph_lo < 0) cg::this_grid().sync();
    const unsigned wave_s = __builtin_amdgcn_readfirstlane(threadIdx.x >> 6);
    for (int ph = ph_lo; ph < ph_hi; ++ph) {
        Ctx cx; { unsigned ln; asm volatile("v_mbcnt_lo_u32_b32 %0, -1, 0\n\tv_mbcnt_hi_u32_b32 %0, -1, %0" : "=v"(ln)); cx.tid = (int)((launder_u32(wave_s) << 6) | ln); }
        cx.bid = (int)launder_u32(blockIdx.x); cx.nb = (int)launder_u32(gridDim.x); cx.plo = 0; cx.phi = 0x7fffffff; cx.pq = cx.bid; cx.pst = cx.nb;
        Params q = p;
        { const unsigned long long ka = (unsigned long long)__builtin_amdgcn_kernarg_segment_ptr(); unsigned long long wsv, outv;
          asm volatile("s_load_dwordx2 %0, %2, 0xb8\n\ts_load_dwordx2 %1, %2, 0xb0\n\ts_waitcnt lgkmcnt(0)" : "=&s"(wsv), "=&s"(outv) : "s"(ka) : "memory");
          q.ws = (unsigned char*)wsv; q.out = (float*)outv; }
        run_phase(cx, q, ph, lds, ldsf);
        if (ph + 1 < ph_hi) { XcdBarrier xbl; xbl.bar = (unsigned*)(q.ws + WS_BAR); xbl.x = launder_u32(xb_x); xbl.st = (volatile LAS unsigned*)(lds + LDS_STAGE); xcd_barrier(xbl); }
    }
}

extern "C" void kernel_launch(void* const* d_in, const int* in_sizes, int n_in, void* d_out, int out_size, void* d_ws, size_t ws_size, hipStream_t stream) {
    static int grid = 0;
    if (grid == 0) {
        if (n_in != 22 || ws_size < WS_END) { fprintf(stderr, "kernel_launch: unexpected n_in %d / ws_size %zu (need %zu)\n", n_in, ws_size, (size_t)WS_END); grid = -1; return; }
        int dev = 0, cus = 0, per_cu = 0;
        hipGetDevice(&dev);
        hipDeviceGetAttribute(&cus, hipDeviceAttributeMultiprocessorCount, dev);
        if (hipFuncSetAttribute((const void*)mk_fwd, hipFuncAttributeMaxDynamicSharedMemorySize, LDS_BYTES) != hipSuccess) { fprintf(stderr, "kernel_launch: hipFuncSetAttribute failed\n"); grid = -1; return; }
        hipOccupancyMaxActiveBlocksPerMultiprocessor(&per_cu, (const void*)mk_fwd, 512, LDS_BYTES);
        if (per_cu < 1) { fprintf(stderr, "kernel_launch: occupancy query says %d blocks/CU\n", per_cu); per_cu = 1; }
        grid = cus * per_cu;
        (void)hipGetLastError();
    }
    if (grid < 0) return;
    if (hipMemsetAsync((char*)d_ws + WS_BAR, 0, XCD_BAR_WORDS * 4, stream) != hipSuccess) { fprintf(stderr, "kernel_launch: memset of barrier words failed\n"); return; }
    Params p{};
    for (int i = 0; i < 22; ++i) p.in[i] = (const float*)d_in[i];
    p.out = (float*)d_out; p.ws = (unsigned char*)d_ws;
#if MK_COOP
    int lo = 0, hi = NPH;
    void* args[] = {&p, &lo, &hi};
    hipError_t e = hipLaunchCooperativeKernel((const void*)mk_fwd, dim3(grid), dim3(512), args, LDS_BYTES, stream);
    if (e != hipSuccess) fprintf(stderr, "cooperative launch failed: %s (grid %d)\n", hipGetErrorString(e), grid);
#else
    for (int ph = 0; ph < NPH; ++ph) hipLaunchKernelGGL(mk_fwd, dim3(grid), dim3(512), LDS_BYTES, stream, p, ph, ph + 1);
#endif
}
```

```cpp
#include <hip/hip_runtime.h>
#include <hip/hip_cooperative_groups.h>
#include <cstdio>
#include <cstdint>
namespace cg = cooperative_groups;

#ifndef MK_COOP
#define MK_COOP 1
#endif

#define LAS __attribute__((address_space(3)))
typedef unsigned short bf16_t;
typedef short bf16x8 __attribute__((ext_vector_type(8)));
typedef short s16x4 __attribute__((ext_vector_type(4)));
typedef float f32x4 __attribute__((ext_vector_type(4)));
typedef float f32x16 __attribute__((ext_vector_type(16)));
typedef unsigned u32x4 __attribute__((ext_vector_type(4)));
typedef unsigned u32x2 __attribute__((ext_vector_type(2)));
typedef __bf16 bfv2 __attribute__((ext_vector_type(2)));
typedef float f32x2 __attribute__((ext_vector_type(2)));
#define DI __device__ __forceinline__
#define GAS __attribute__((address_space(1)))
template <class T> __device__ __forceinline__ const GAS T* gp(const T* p) { return (const GAS T*)p; }
template <class T> __device__ __forceinline__ GAS T* gpw(T* p) { return (GAS T*)p; }
#define MFMA32(a, b, c) __builtin_amdgcn_mfma_f32_32x32x16_bf16((a), (b), (c), 0, 0, 0)

constexpr int DM = 1024, NBATCH = 8, SEQ = 2048, MTOK = NBATCH * SEQ, DFF = 2816, NUP = 2 * DFF;
constexpr size_t MiB = 1ull << 20;
constexpr size_t WS_ROPE = 0, WS_BAR = 1 * MiB, WS_H = 2 * MiB, WS_HB = 66 * MiB, WS_W1IN = 98 * MiB, WS_W1OUT = 109 * MiB, WS_W2IN = 115 * MiB,
                 WS_W2OUT = 126 * MiB, WS_WMIX = 132 * MiB, WS_WKV = 140 * MiB, WS_KVN = 146 * MiB, WS_KVT = 178 * MiB, WS_KC = 194 * MiB,
                 WS_VCT = 194 * MiB + 512 * 1024, WS_S = 196 * MiB, WS_RP = 324 * MiB, WS_CMP = 326 * MiB, WS_END = 362 * MiB;
constexpr int NPH = 30;
constexpr int LDS_STAGE = 131072, LDS_RQ = LDS_STAGE + 64, LDS_BYTES = LDS_RQ + 4096;

struct Params { const float* in[22]; float* out; unsigned char* ws; };
struct Ctx { int tid, bid, nb, plo, phi, pq, pst; };
#define IN(i) launder_ptr(p.in[i])
__device__ __forceinline__ unsigned launder_u32(unsigned x) { unsigned y; asm volatile("v_mov_b32 %0, %1" : "=v"(y) : "s"(x)); return __builtin_amdgcn_readfirstlane(y); }
template <class T> __device__ __forceinline__ T* launder_ptr(T* p) { const unsigned long long v = (unsigned long long)p; const unsigned lo = launder_u32((unsigned)v), hi = launder_u32((unsigned)(v >> 32)); return (T*)(((unsigned long long)hi << 32) | lo); }

DI unsigned pk2(float lo, float hi) { f32x2 v = {lo, hi}; bfv2 b = __builtin_convertvector(v, bfv2); return __builtin_bit_cast(unsigned, b); }
DI float bf2f(unsigned short b) { return __uint_as_float(((unsigned)b) << 16); }
DI float bflo(unsigned u) { return __uint_as_float(u << 16); }
DI float bfhi(unsigned u) { return __uint_as_float(u & 0xffff0000u); }
typedef unsigned long long u64;
DI float rstd_of(const u64* p) { const float ss = (float)(*p) * (1.0f / 1048576.0f); return rsqrtf(ss * (1.0f / 1024.0f) + 1e-6f); }
DI u64 ss_fix(float ss) { return (u64)(ss * 1048576.0f + 0.5f); }
DI void lds_barrier() { asm volatile("s_waitcnt lgkmcnt(0)" ::: "memory"); __builtin_amdgcn_s_barrier(); asm volatile("" ::: "memory"); }
DI float silu_f(float a) { return a * __builtin_amdgcn_rcpf(1.0f + __expf(-a)); }

namespace pg8 {
constexpr int BM = 256, BK = 64, HALF = 128, HTB = HALF * BK * 2, STAGE_BYTES = 8 * HTB, NXCD = 8, WGM = 8;
DI int lds_byte(int r, int c) { const int st = (r >> 4) * 2 + (c >> 5), rr = r & 15, cc = c & 31, ob = rr * 64 + cc * 2; return st * 1024 + (ob ^ (((ob >> 9) & 1) << 5)); }
DI void stage_rc(int b, int& R, int& C) { const int st = b / 1024, sb = b % 1024, swz = sb ^ (((sb >> 9) & 1) << 5); R = (st >> 1) * 16 + swz / 64; C = (st & 1) * 32 + (swz % 64) / 2; }
DI int perm32(int rho) { const int n = rho >> 4, i = rho & 15; return 8 * (i >> 2) + 4 * n + (i & 3); }
struct Unit { int pm, pn; };
struct Gemm { const bf16_t* A; const bf16_t* Bt; int M, N, K; };
struct StaticOrder {
    int nM, nN, nwg, G, c;
    DI void init(int M, int N, int G_, int c_) { nM = M / BM; nN = N / BM; nwg = nM * nN; G = G_; c = c_; }
    DI bool next(int i, Unit& u) const {
        const long L = (long)i * G + c; if (L >= nwg) return false;
        int wgid = (int)L; { const int q = nwg / NXCD, r = nwg % NXCD, xcd = wgid % NXCD, off = wgid / NXCD; wgid = (xcd < r ? xcd * (q + 1) : r * (q + 1) + (xcd - r) * q) + off; }
        const int nig = WGM * nN, gid = wgid / nig, fm = gid * WGM, gsz = (nM - fm) < WGM ? (nM - fm) : WGM;
        u.pm = fm + ((wgid % nig) % gsz); u.pn = (wgid % nig) / gsz; return true;
    }
};

enum { EP_U = 0, EP_RES = 1, EP_SCALE = 2, EP_SCALET = 3, EP_SILU = 4 };
struct EpiKey { unsigned char* ws; float* out; const float* x; int L, k, i, nb; };
struct EpiFields { const u64* rowss; bf16_t* ob; int ldo; const float* hsrc; float* hdst; bf16_t* hb; void* hlo; u64* rowss_out; float alpha; };
DI void epi_resolve(const EpiKey& key, EpiFields& f);
template <int MODE> struct Epi {
    static constexpr bool PERM = true;
    static constexpr bool HAS_RQ = (MODE == EP_U || MODE == EP_SCALE || MODE == EP_SCALET);
    static constexpr bool RQ_COL = (MODE == EP_SCALET);
    EpiKey key;
    DI void operator()(const f32x4 (&acc)[2][2][4][2], const Unit& u, int wr, int wc, int fr, int fq, const LAS unsigned char* rqL) const {
        EpiFields F; epi_resolve(key, F);
        const u64* rowss = F.rowss; bf16_t* ob = F.ob; const int ldo = F.ldo; const float* hsrc = F.hsrc; float* hdst = F.hdst; bf16_t* hb = F.hb; u64* rowss_out = F.rowss_out; const float alpha = F.alpha;
        if constexpr (MODE == EP_U) {
            const int row0 = u.pm * BM + wr * 64 + fr, col0 = u.pn * 128 + wc * 32 + 8 * fq;
            u64 rq[2][4];
#pragma unroll
            for (int ai = 0; ai < 2; ++ai)
#pragma unroll
                for (int m = 0; m < 4; ++m) rq[ai][m] = *(const LAS u64*)(rqL + (wr * 64 + fr + ai * HALF + m * 16) * 8);
#pragma unroll
            for (int ai = 0; ai < 2; ++ai)
#pragma unroll
                for (int m = 0; m < 4; ++m) {
                    const int row = row0 + ai * HALF + m * 16; const float rs = rstd_of(&rq[ai][m]);
                    float o[8];
#pragma unroll
                    for (int n = 0; n < 2; ++n)
#pragma unroll
                        for (int j = 0; j < 4; ++j) { const float a = acc[ai][0][m][n][j] * rs, b = acc[ai][1][m][n][j] * rs; o[4 * n + j] = silu_f(a) * b; }
                    u32x4 w; w.x = pk2(o[0], o[1]); w.y = pk2(o[2], o[3]); w.z = pk2(o[4], o[5]); w.w = pk2(o[6], o[7]);
                    *gpw((u32x4*)(ob + (size_t)row * ldo + col0)) = w;
                }
        } else if constexpr (MODE == EP_RES) {
            const int row0 = u.pm * BM + wr * 64 + fr, col0 = u.pn * BM + wc * 32 + 8 * fq;
            bf16_t* lo = (bf16_t*)F.hlo;
            u32x4 ld0[2][2], ld1[2][2];
            auto issue = [&](int am, int slot) {
                const int ai = am >> 2, m = am & 3;
#pragma unroll
                for (int bj = 0; bj < 2; ++bj) {
                    const size_t off = (size_t)(row0 + ai * HALF + m * 16) * DM + col0 + bj * HALF;
                    if (hsrc) { ld0[slot][bj] = *gp((const u32x4*)(hsrc + off)); ld1[slot][bj] = *gp((const u32x4*)(hsrc + off + 4)); }
                    else { ld0[slot][bj] = *gp((const u32x4*)(hb + off)); ld1[slot][bj] = *gp((const u32x4*)(lo + off)); }
                }
            };
            issue(0, 0);
#pragma unroll
            for (int am = 0; am < 8; ++am) {
                const int ai = am >> 2, m = am & 3, slot = am & 1;
                const int row = row0 + ai * HALF + m * 16; float ss = 0.f;
                if (am + 1 < 8) issue(am + 1, slot ^ 1);
#pragma unroll
                for (int bj = 0; bj < 2; ++bj) {
                    const size_t off = (size_t)row * DM + col0 + bj * HALF;
                    float v[8];
                    if (hsrc) {
#pragma unroll
                        for (int j = 0; j < 4; ++j) { v[j] = __uint_as_float(ld0[slot][bj][j]); v[4 + j] = __uint_as_float(ld1[slot][bj][j]); }
                    } else {
#pragma unroll
                        for (int q = 0; q < 4; ++q) { v[2 * q] = bflo(ld0[slot][bj][q]) + bflo(ld1[slot][bj][q]); v[2 * q + 1] = bfhi(ld0[slot][bj][q]) + bfhi(ld1[slot][bj][q]); }
                    }
#pragma unroll
                    for (int n = 0; n < 2; ++n)
#pragma unroll
                        for (int j = 0; j < 4; ++j) { v[4 * n + j] += alpha * acc[ai][bj][m][n][j]; ss += v[4 * n + j] * v[4 * n + j]; }
                    if (hdst) {
                        f32x4 a, b;
#pragma unroll
                        for (int j = 0; j < 4; ++j) { a[j] = v[j]; b[j] = v[4 + j]; }
                        *gpw((f32x4*)(hdst + off)) = a; *gpw((f32x4*)(hdst + off + 4)) = b;
                    } else {
                        u32x4 hi4, lo4;
#pragma unroll
                        for (int q = 0; q < 4; ++q) { hi4[q] = pk2(v[2 * q], v[2 * q + 1]); lo4[q] = pk2(v[2 * q] - bflo(hi4[q]), v[2 * q + 1] - bfhi(hi4[q])); }
                        *gpw((u32x4*)(hb + off)) = hi4; *gpw((u32x4*)(lo + off)) = lo4;
                    }
                }
                if (rowss_out) { ss += __shfl_xor(ss, 16); ss += __shfl_xor(ss, 32); if (fq == 0) (void)__hip_atomic_fetch_add(gpw(rowss_out + row), ss_fix(ss), __ATOMIC_RELAXED, __HIP_MEMORY_SCOPE_AGENT); }
            }
        } else if constexpr (MODE == EP_SCALE || MODE == EP_SILU) {
            const int row0 = u.pm * BM + wr * 64 + fr, col0 = u.pn * BM + wc * 32 + 8 * fq;
            u64 rq[2][4];
#pragma unroll
            for (int ai = 0; ai < 2; ++ai)
#pragma unroll
                for (int m = 0; m < 4; ++m) { if constexpr (MODE == EP_SCALE) rq[ai][m] = *(const LAS u64*)(rqL + (wr * 64 + fr + ai * HALF + m * 16) * 8); else rq[ai][m] = 1ull; }
#pragma unroll
            for (int ai = 0; ai < 2; ++ai)
#pragma unroll
                for (int m = 0; m < 4; ++m) {
                    const int row = row0 + ai * HALF + m * 16; float rs = 1.f; if constexpr (MODE == EP_SCALE) rs = rstd_of(&rq[ai][m]);
#pragma unroll
                    for (int bj = 0; bj < 2; ++bj) {
                        float o[8];
#pragma unroll
                        for (int n = 0; n < 2; ++n)
#pragma unroll
                            for (int j = 0; j < 4; ++j) { float a = acc[ai][bj][m][n][j] * rs; if constexpr (MODE == EP_SILU) a = silu_f(a); o[4 * n + j] = a; }
                        u32x4 w; w.x = pk2(o[0], o[1]); w.y = pk2(o[2], o[3]); w.z = pk2(o[4], o[5]); w.w = pk2(o[6], o[7]);
                        *gpw((u32x4*)(ob + (size_t)row * ldo + col0 + bj * HALF)) = w;
                    }
                }
        } else {
            const int row0 = u.pm * BM + wr * 64 + fr, col0 = u.pn * BM + wc * 32 + 8 * fq;
            float rs[2][8]; u64 rq[2][8];
#pragma unroll
            for (int bj = 0; bj < 2; ++bj)
#pragma unroll
                for (int j = 0; j < 8; ++j) rq[bj][j] = *(const LAS u64*)(rqL + (wc * 32 + 8 * fq + bj * HALF + j) * 8);
#pragma unroll
            for (int bj = 0; bj < 2; ++bj)
#pragma unroll
                for (int j = 0; j < 8; ++j) rs[bj][j] = rstd_of(&rq[bj][j]);
#pragma unroll
            for (int ai = 0; ai < 2; ++ai)
#pragma unroll
                for (int m = 0; m < 4; ++m) {
                    const int row = row0 + ai * HALF + m * 16;
#pragma unroll
                    for (int bj = 0; bj < 2; ++bj) {
                        float o[8];
#pragma unroll
                        for (int n = 0; n < 2; ++n)
#pragma unroll
                            for (int j = 0; j < 4; ++j) o[4 * n + j] = acc[ai][bj][m][n][j] * rs[bj][4 * n + j];
                        u32x4 w; w.x = pk2(o[0], o[1]); w.y = pk2(o[2], o[3]); w.z = pk2(o[4], o[5]); w.w = pk2(o[6], o[7]);
                        *gpw((u32x4*)(ob + (size_t)row * ldo + col0 + bj * HALF)) = w;
                    }
                }
        }
    }
};

template <class EpiT>
DI void gemm_phase(const Ctx& cx, LAS unsigned char* lds, const Gemm g, const StaticOrder& S, const EpiT& E, const u64* rqbase = nullptr) {
    const int tid = cx.tid, wid = __builtin_amdgcn_readfirstlane(tid >> 6), lane = tid & 63, wr = wid >> 2, wc = wid & 3, fr = lane & 15, fq = lane >> 4;
    const int K = g.K, nt = K / BK;
    unsigned voffA[2], voffB[2];
#pragma unroll
    for (int i = 0; i < 2; ++i) { int R, C; stage_rc(tid * 16 + i * 8192, R, C); const int Rb = EpiT::PERM ? ((R & ~31) + perm32(R & 31)) : R;
        voffA[i] = (unsigned)(R * K + C) * 2u; voffB[i] = (unsigned)(Rb * K + C) * 2u; }
    const size_t kstep = (size_t)(BK * 2);
    const size_t hstep = (size_t)HALF * K * 2;
    const size_t tstep = 2 * hstep;
    const unsigned ldsw = (unsigned)wid * 1024u;
    const int aoff = lds_byte(wr * 64 + fr, fq * 8), boff = lds_byte(wc * 32 + fr, fq * 8);
#define PG8_SA(b, h) (((b) * 2 + (h)) * HTB)
#define PG8_SB(b, h) ((4 + (b) * 2 + (h)) * HTB)
#define PG8_STAGE(bufoff, gbase, voff) do { _Pragma("unroll") for (int _i = 0; _i < 2; ++_i) \
        __builtin_amdgcn_global_load_lds((const unsigned*)((const char*)(gbase) + (voff)[_i]), (LAS unsigned*)(lds + (bufoff) + ldsw + _i * 8192), 16, 0, 0); } while (0)
#define PG8_LDA(dst, b, h) do { _Pragma("unroll") for (int m = 0; m < 4; ++m) _Pragma("unroll") for (int k = 0; k < 2; ++k) dst[m][k] = *(const LAS bf16x8*)(lds + PG8_SA(b, h) + aoff + m * 2048 + k * 1024); } while (0)
#define PG8_LDB(dst, b, h) do { _Pragma("unroll") for (int n = 0; n < 2; ++n) _Pragma("unroll") for (int k = 0; k < 2; ++k) dst[n][k] = *(const LAS bf16x8*)(lds + PG8_SB(b, h) + boff + n * 2048 + k * 1024); } while (0)
#define PG8_MMA(ai, bj, At, Bt) do { __builtin_amdgcn_s_setprio(1); _Pragma("unroll") for (int m = 0; m < 4; ++m) _Pragma("unroll") for (int n = 0; n < 2; ++n) _Pragma("unroll") for (int k = 0; k < 2; ++k) \
        acc[ai][bj][m][n] = __builtin_amdgcn_mfma_f32_16x16x32_bf16(Bt[n][k], At[m][k], acc[ai][bj][m][n], 0, 0, 0); __builtin_amdgcn_s_setprio(0); } while (0)
#define PG8_WAIT_V(n) asm volatile("s_waitcnt vmcnt(" #n ")" ::: "memory")
#define PG8_WAIT_L(n) asm volatile("s_waitcnt lgkmcnt(" #n ")" ::: "memory")
#define PG8_BAR __builtin_amdgcn_s_barrier()
#define PG8_SCHED __builtin_amdgcn_sched_barrier(0)
    Unit cur, nxt; int ui = 0;
    if (!S.next(0, cur)) return;
    f32x4 acc[2][2][4][2];
#pragma unroll
    for (int a = 0; a < 2; ++a)
#pragma unroll
        for (int b = 0; b < 2; ++b)
#pragma unroll
            for (int m = 0; m < 4; ++m)
#pragma unroll
                for (int n = 0; n < 2; ++n) acc[a][b][m][n] = (f32x4){0.f, 0.f, 0.f, 0.f};
    bf16x8 At[4][2], B0[2][2], B1[2][2];
    const char* cA = (const char*)g.A + (size_t)cur.pm * tstep; const char* cB = (const char*)g.Bt + (size_t)cur.pn * tstep;
#define PG8_RQ(unit, par) do { if (EpiT::HAS_RQ && wid < 2) __builtin_amdgcn_global_load_lds((const unsigned*)(rqbase + (EpiT::RQ_COL ? (unit).pn : (unit).pm) * BM + 128 * wid + 2 * lane), \
        (LAS unsigned*)(lds + LDS_RQ + (par) * 2048 + wid * 1024), 16, 0, 0); } while (0)
    PG8_RQ(cur, 0);
    PG8_STAGE(PG8_SB(0, 0), cB, voffB); PG8_STAGE(PG8_SA(0, 0), cA, voffA); PG8_STAGE(PG8_SB(0, 1), cB + hstep, voffB); PG8_STAGE(PG8_SA(0, 1), cA + hstep, voffA);
    if (wr == 1) PG8_BAR;
    PG8_WAIT_V(4); PG8_BAR;
    PG8_STAGE(PG8_SB(1, 0), cB + kstep, voffB); PG8_STAGE(PG8_SA(1, 0), cA + kstep, voffA); PG8_STAGE(PG8_SB(1, 1), cB + hstep + kstep, voffB);
    PG8_WAIT_V(6); PG8_BAR;
    for (;;) {
        const bool has_next = S.next(ui + 1, nxt);
        const char* nA = has_next ? (const char*)g.A + (size_t)nxt.pm * tstep : cA; const char* nB = has_next ? (const char*)g.Bt + (size_t)nxt.pn * tstep : cB;
        for (int t = 0; t < nt; t += 2) {
            const bool last = (t == nt - 2);
            const char* a1 = cA + (size_t)(t + 1) * kstep;
            const char* a2 = last ? nA : cA + (size_t)(t + 2) * kstep; const char* b2 = last ? nB : cB + (size_t)(t + 2) * kstep;
            const char* a3 = a2 + kstep; const char* b3 = b2 + kstep;
            PG8_LDB(B0, 0, 0); PG8_SCHED; PG8_LDA(At, 0, 0); PG8_STAGE(PG8_SA(1, 1), a1 + hstep, voffA);
            PG8_WAIT_L(8); PG8_BAR; PG8_WAIT_L(0); PG8_MMA(0, 0, At, B0); PG8_BAR; PG8_SCHED;
            PG8_LDB(B1, 0, 1); PG8_STAGE(PG8_SB(0, 0), b2, voffB);
            PG8_BAR; PG8_WAIT_L(0); PG8_MMA(0, 1, At, B1); PG8_BAR;
            PG8_LDA(At, 0, 1); PG8_STAGE(PG8_SA(0, 0), a2, voffA);
            PG8_BAR; PG8_WAIT_L(0); PG8_MMA(1, 0, At, B0); PG8_BAR; PG8_SCHED;
            PG8_STAGE(PG8_SB(0, 1), b2 + hstep, voffB);
            PG8_WAIT_V(6); PG8_BAR; PG8_MMA(1, 1, At, B1); PG8_BAR;
            PG8_LDB(B0, 1, 0); PG8_SCHED; PG8_LDA(At, 1, 0); PG8_STAGE(PG8_SA(0, 1), a2 + hstep, voffA);
            PG8_WAIT_L(8); PG8_BAR; PG8_WAIT_L(0); PG8_MMA(0, 0, At, B0); PG8_BAR; PG8_SCHED;
            PG8_LDB(B1, 1, 1); PG8_STAGE(PG8_SB(1, 0), b3, voffB);
            PG8_BAR; PG8_WAIT_L(0); PG8_MMA(0, 1, At, B1); PG8_BAR;
            PG8_LDA(At, 1, 1); PG8_STAGE(PG8_SA(1, 0), a3, voffA);
            PG8_BAR; PG8_WAIT_L(0); PG8_MMA(1, 0, At, B0); PG8_BAR; PG8_SCHED;
            PG8_STAGE(PG8_SB(1, 1), b3 + hstep, voffB);
            PG8_WAIT_V(6); PG8_BAR; PG8_MMA(1, 1, At, B1); PG8_BAR;
        }
        E(acc, cur, wr, wc, fr, fq, lds + LDS_RQ + (ui & 1) * 2048);
        if (has_next) PG8_RQ(nxt, (ui + 1) & 1);
        if (!has_next) break;
#pragma unroll
        for (int a = 0; a < 2; ++a)
#pragma unroll
            for (int b = 0; b < 2; ++b)
#pragma unroll
                for (int m = 0; m < 4; ++m)
#pragma unroll
                    for (int n = 0; n < 2; ++n) acc[a][b][m][n] = (f32x4){0.f, 0.f, 0.f, 0.f};
        cur = nxt; cA = nA; cB = nB; ++ui;
    }
    PG8_WAIT_V(0);
    if (wr == 0) PG8_BAR;
    PG8_BAR;
#undef PG8_RQ
#undef PG8_SA
#undef PG8_SB
#undef PG8_STAGE
#undef PG8_LDA
#undef PG8_LDB
#undef PG8_MMA
#undef PG8_WAIT_V
#undef PG8_WAIT_L
#undef PG8_BAR
#undef PG8_SCHED
}
}

template <int MODE>
DI void run_gemm(const Ctx& cx, LAS unsigned char* lds, const bf16_t* A, const bf16_t* Bt, int M, int N, int K, const pg8::Epi<MODE>& E) {
    pg8::Gemm g; g.A = A; g.Bt = Bt; g.M = M; g.N = N; g.K = K;
    pg8::StaticOrder S; S.init(M, N, (int)cx.nb, (int)cx.bid);
    pg8::gemm_phase(cx, lds, g, S, E);
}

DI void transpose_load(const float* __restrict__ src, int ld, int ntk, int type, int col0, int nvalid, const float* __restrict__ gain, int t, int n4, int kq, f32x4 (&v)[4], float (&gv)[4]) {
    const int tn = t / ntk, tk = t - tn * ntk;
    const int n0 = tn * 64, k0 = tk * 128;
    int c0;
    if (type == 1) { const int pn = n0 >> 8, w = n0 & 255; c0 = (w >> 7) * DFF + 128 * pn + (w & 127); } else c0 = col0 + n0;
    const int col = c0 + 4 * n4, colc = col < nvalid ? col : nvalid - 4;
    const float* gsrc = gain ? gain : src;
#pragma unroll
    for (int i = 0; i < 4; ++i) {
        const int kk = k0 + kq + 32 * i;
        f32x4 x = *gp((const f32x4*)(src + (size_t)kk * ld + colc));
        if (col >= nvalid) x = (f32x4){0.f, 0.f, 0.f, 0.f};
        const float gl = *gp(gsrc + kk);
        gv[i] = gain ? gl : 1.0f;
        v[i] = x;
    }
}
DI void transpose_job(const Ctx& cx, const float* __restrict__ src, int ld, int K, int Nd, int type, int col0, int nvalid, const float* __restrict__ gain, bf16_t* __restrict__ dst, LAS float* tile, int& tbase, float scale = 1.0f) {
    const int tid = cx.tid;
    const int ntk = K >> 7, nt = ntk * (Nd >> 6);
    const int n4 = tid & 15, kq = tid >> 4;
    const int Tlo = cx.plo > tbase ? cx.plo : tbase, Thi = cx.phi < tbase + nt ? cx.phi : tbase + nt;
    int T = Tlo + ((cx.pq - (Tlo - cx.plo)) % cx.pst + cx.pst) % cx.pst;
    f32x4 cur[4], nxt[4]; float gc[4], gn[4];
    if (T < Thi) transpose_load(src, ld, ntk, type, col0, nvalid, gain, T - tbase, n4, kq, cur, gc);
    for (; T < Thi; T += cx.pst) {
        const int t = T - tbase;
        transpose_load(src, ld, ntk, type, col0, nvalid, gain, (T + cx.pst < Thi) ? t + cx.pst : t, n4, kq, nxt, gn);
        const int tn = t / ntk, tk = t - tn * ntk;
        const int n0 = tn * 64, k0 = tk * 128;
#pragma unroll
        for (int i = 0; i < 4; ++i)
#pragma unroll
            for (int e = 0; e < 4; ++e) tile[(kq + 32 * i) * 65 + 4 * n4 + e] = cur[i][e] * (gc[i] * scale);
        lds_barrier();
#pragma unroll
        for (int i = 0; i < 2; ++i) {
            const int c = tid + 512 * i, n = c & 63, k8 = (c >> 6) * 8;
            float o[8];
#pragma unroll
            for (int j = 0; j < 8; ++j) o[j] = tile[(k8 + j) * 65 + n];
            u32x4 w; w.x = pk2(o[0], o[1]); w.y = pk2(o[2], o[3]); w.z = pk2(o[4], o[5]); w.w = pk2(o[6], o[7]);
            *gpw((u32x4*)(dst + (size_t)(n0 + n) * K + k0 + k8)) = w;
        }
        lds_barrier();
#pragma unroll
        for (int i = 0; i < 4; ++i) { cur[i] = nxt[i]; gc[i] = gn[i]; }
    }
    tbase += nt;
}

DI void prep_w1in(const Ctx& cx, const Params& p, int L, LAS float* tile, int& tb) {
    transpose_job(cx, IN(2) + (size_t)L * DM * NUP, NUP, DM, NUP, 1, 0, NUP, IN(1) + L * DM, (bf16_t*)(p.ws + WS_W1IN), tile, tb);
}
DI void prep_w1out(const Ctx& cx, const Params& p, int L, LAS float* tile, int& tb) {
    transpose_job(cx, IN(3) + (size_t)L * DFF * DM, DM, DFF, DM, 0, 0, DM, nullptr, (bf16_t*)(p.ws + WS_W1OUT), tile, tb);
}
DI void prep_w2(const Ctx& cx, const Params& p, int L, LAS float* tile, int& tb) {
    unsigned char* ws = p.ws;
    transpose_job(cx, IN(6) + (size_t)L * DM * NUP, NUP, DM, NUP, 1, 0, NUP, IN(5) + L * DM, (bf16_t*)(ws + WS_W2IN), tile, tb);
    transpose_job(cx, IN(7) + (size_t)L * DFF * DM, DM, DFF, DM, 0, 0, DM, nullptr, (bf16_t*)(ws + WS_W2OUT), tile, tb);
}
DI void prep_wmix(const Ctx& cx, const Params& p, int L, LAS float* tile, int& tb) {
    unsigned char* ws = p.ws;
    if (L < 2) {
        const float* wq = IN(8) + (size_t)L * DM * 3072;
        transpose_job(cx, wq, 3072, DM, 1024, 0, 0, 3072, IN(4) + L * DM, (bf16_t*)(ws + WS_WMIX), tile, tb, 0.125f * 1.4426950408889634f);
        transpose_job(cx, wq, 3072, DM, 1024, 0, 1024, 3072, IN(4) + L * DM, (bf16_t*)(ws + WS_WMIX) + (size_t)1024 * DM, tile, tb);
        transpose_job(cx, wq, 3072, DM, 1024, 0, 2048, 3072, IN(4) + L * DM, (bf16_t*)(ws + WS_WMIX + 4 * MiB), tile, tb);
        transpose_job(cx, IN(9) + (size_t)L * DM * DM, DM, DM, DM, 0, 0, DM, nullptr, (bf16_t*)(ws + WS_WMIX + 6 * MiB), tile, tb);
    } else {
        transpose_job(cx, IN(19) + (size_t)(L - 2) * DM * 1072, 1072, DM, 1280, 0, 0, 1072, IN(4) + L * DM, (bf16_t*)(ws + WS_WMIX), tile, tb);
        transpose_job(cx, IN(21) + (size_t)(L - 2) * DM * DM, DM, DM, DM, 0, 0, DM, nullptr, (bf16_t*)(ws + WS_WMIX + 6 * MiB), tile, tb);
    }
}
DI void prep_phase(const Ctx& cx, const Params& p, int L, LAS float* tile) {
    int tb = 0;
    unsigned char* ws = p.ws;
    const int tid = cx.tid, gtid = cx.bid * 512 + tid, gsz = cx.nb * 512;
    if (L == 0) {
        float2* rope = (float2*)(ws + WS_ROPE);
        for (int i = gtid; i < SEQ * 8; i += gsz) {
            const int t = i >> 3, f = i & 7;
            const float inv = exp2f(-(float)f * 0.125f * 18.931568569324174f);
            const float ang = (float)t * inv; float rev = ang * 0.15915494309189535f; rev -= floorf(rev);
            rope[i] = make_float2(__builtin_amdgcn_cosf(rev), __builtin_amdgcn_sinf(rev));
        }
        u64* rowss = (u64*)(ws + WS_RP);
        { unsigned z = 0u; asm volatile("" : "+v"(z));
          const u64 zz = ((u64)z << 32) | z;
          for (int i = gtid; i < 12 * MTOK; i += gsz) *gpw(rowss + MTOK + i) = zz; }
        const float* x = IN(0); bf16_t* hb = (bf16_t*)(ws + WS_HB);
        const int lane = tid & 63, gw = gtid >> 6, nw = gsz >> 6;
        for (int row = gw; row < MTOK; row += nw) {
            float ss = 0.f;
#pragma unroll
            for (int i = 0; i < 4; ++i) {
                const size_t off = (size_t)row * DM + i * 256 + lane * 4;
                const f32x4 v = *gp((const f32x4*)(x + off));
                ss += v[0] * v[0] + v[1] * v[1] + v[2] * v[2] + v[3] * v[3];
                u32x2 w; w.x = pk2(v[0], v[1]); w.y = pk2(v[2], v[3]); *gpw((u32x2*)(hb + off)) = w;
            }
#pragma unroll
            for (int o = 32; o > 0; o >>= 1) ss += __shfl_xor(ss, o);
            if (lane == 0) rowss[row] = ss_fix(ss);
        }
        bf16_t* kvn_t = (bf16_t*)(ws + WS_WKV); bf16_t* kvT_t = (bf16_t*)(ws + WS_WKV + 2 * MiB);
        const int cn[4] = {0, 256, 512, 1024};
#pragma unroll
        for (int i = 0; i < 4; ++i) transpose_job(cx, IN(11), 1536, 1024, 256, 0, cn[i], 1536, IN(10), kvn_t + (size_t)i * 256 * 1024, tile, tb);
        transpose_job(cx, IN(11), 1536, 1024, 256, 0, 768, 1536, IN(10), kvT_t, tile, tb);
        transpose_job(cx, IN(11), 1536, 1024, 256, 0, 1280, 1536, IN(10), kvT_t + (size_t)256 * 1024, tile, tb);
        transpose_job(cx, IN(15), 256, 2048, 256, 0, 0, 256, nullptr, (bf16_t*)(ws + WS_WKV + 3 * MiB), tile, tb);
        transpose_job(cx, IN(17), 256, 2048, 256, 0, 0, 256, nullptr, (bf16_t*)(ws + WS_WKV + 4 * MiB), tile, tb);
    }
    prep_w1in(cx, p, 0, tile, tb);
}

DI void sb_attn_phase(const Ctx& cx, const Params& p) {
    const bf16_t* qk = (const bf16_t*)(p.ws + WS_S);
    const bf16_t* vt = (const bf16_t*)(p.ws + WS_S + 64 * MiB);
    bf16_t* ao = (bf16_t*)(p.ws + WS_S + 96 * MiB);
    const int lane = cx.tid & 63, wid = cx.tid >> 6, r = lane & 31, h = lane >> 5;
    for (int item = cx.bid; item < 1024; item += cx.nb) {
        const int sblk = item & 255, pair = (item >> 8) * 32 + (sblk & 7) * 4 + (sblk >> 6), qt = (sblk >> 3) & 7;
        const int b = pair >> 4, head = pair & 15;
        const int tok0 = b * SEQ, t0 = qt * 256 + wid * 32;
        bf16x8 qf[4];
#pragma unroll
        for (int s = 0; s < 4; ++s) qf[s] = *gp((const bf16x8*)(qk + (size_t)(tok0 + t0 + r) * 2048 + head * 64 + 16 * s + 8 * h));
        f32x16 o[2];
#pragma unroll
        for (int i = 0; i < 16; ++i) { o[0][i] = 0.f; o[1][i] = 0.f; }
        float carry = 1.0f;
        for (int kt = t0 >> 5; kt >= 0; --kt) {
            const int s0 = kt * 32; const bool diag = (s0 == t0);
            f32x16 x;
#pragma unroll
            for (int i = 0; i < 16; ++i) x[i] = 0.f;
#pragma unroll
            for (int s = 0; s < 4; ++s) {
                const bf16x8 kf = *gp((const bf16x8*)(qk + (size_t)(tok0 + s0 + r) * 2048 + 1024 + head * 64 + 16 * s + 8 * h));
                x = MFMA32(kf, qf[s], x);
            }
            bf16x8 vf[2][2];
#pragma unroll
            for (int db = 0; db < 2; ++db)
#pragma unroll
                for (int s2 = 0; s2 < 2; ++s2) {
                    const bf16_t* vp = vt + (size_t)(head * 64 + 32 * db + r) * MTOK + tok0 + s0 + 16 * s2 + 4 * h;
                    const s16x4 lo = *gp((const s16x4*)vp), hi = *gp((const s16x4*)(vp + 8));
                    vf[db][s2] = __builtin_shufflevector(lo, hi, 0, 1, 2, 3, 4, 5, 6, 7);
                }
            float c[16], bt[16];
#pragma unroll
            for (int i = 0; i < 16; ++i) {
                const float E = fminf(__builtin_amdgcn_exp2f(x[i]), 1e30f);
                c[i] = __builtin_amdgcn_rcpf(1.0f + E);
                bt[i] = E * c[i];
            }
            if (diag) {
#pragma unroll
                for (int i = 0; i < 16; ++i) { const int kl = (i & 3) + 8 * (i >> 2) + 4 * h; const bool past = kl < r; c[i] = past ? c[i] : 1.0f; bt[i] = past ? bt[i] : 0.f; }
            }
            float gp[4], pp[4], T[4];
#pragma unroll
            for (int g = 0; g < 4; ++g) { gp[g] = (c[4 * g] * c[4 * g + 1]) * (c[4 * g + 2] * c[4 * g + 3]); pp[g] = __shfl_xor(gp[g], 32); T[g] = gp[g] * pp[g]; }
            float R[4]; R[3] = 1.0f; R[2] = T[3]; R[1] = T[3] * T[2]; R[0] = R[1] * T[1];
            float w[16];
#pragma unroll
            for (int g = 0; g < 4; ++g) {
                const float A = carry * R[g] * (h == 0 ? pp[g] : 1.0f);
                const float e2 = c[4 * g + 3], e1 = e2 * c[4 * g + 2], e0 = e1 * c[4 * g + 1];
                w[4 * g + 0] = bt[4 * g + 0] * (A * e0);
                w[4 * g + 1] = bt[4 * g + 1] * (A * e1);
                w[4 * g + 2] = bt[4 * g + 2] * (A * e2);
                w[4 * g + 3] = bt[4 * g + 3] * A;
            }
            carry *= (T[0] * T[1]) * (T[2] * T[3]);
#pragma unroll
            for (int s2 = 0; s2 < 2; ++s2) {
                u32x4 pw; pw.x = pk2(w[8 * s2 + 0], w[8 * s2 + 1]); pw.y = pk2(w[8 * s2 + 2], w[8 * s2 + 3]); pw.z = pk2(w[8 * s2 + 4], w[8 * s2 + 5]); pw.w = pk2(w[8 * s2 + 6], w[8 * s2 + 7]);
                const bf16x8 pf = __builtin_bit_cast(bf16x8, pw);
                o[0] = MFMA32(vf[0][s2], pf, o[0]);
                o[1] = MFMA32(vf[1][s2], pf, o[1]);
            }
#ifndef SB_NO_EARLY_EXIT
            if (__all(carry < 1e-37f)) break;
#endif
        }
#pragma unroll
        for (int db = 0; db < 2; ++db)
#pragma unroll
            for (int g = 0; g < 4; ++g) {
                u32x2 w; w.x = pk2(o[db][4 * g], o[db][4 * g + 1]); w.y = pk2(o[db][4 * g + 2], o[db][4 * g + 3]);
                *gpw((u32x2*)(ao + (size_t)(tok0 + t0 + r) * DM + head * 64 + 32 * db + 8 * g + 4 * h)) = w;
            }
    }
}

DI void kv_prep_phase(const Ctx& cx, const Params& p) {
    unsigned char* ws = p.ws;
    bf16_t* kvn = (bf16_t*)(ws + WS_KVN);
    const float2* rope = (const float2*)(ws + WS_ROPE);
    const int gtid = cx.bid * 512 + cx.tid, gsz = cx.nb * 512;
    for (int i = gtid; i < MTOK * 8; i += gsz) {
        const int tok = i >> 3, which = (i >> 2) & 1, g = i & 3;
        bf16_t* ptr = kvn + (size_t)tok * 1024 + (2 + which) * 256 + g * 64;
        const float* gn = IN(12) + (1 + which) * 64;
        u32x4 raw[8]; float v[64];
#pragma unroll
        for (int c = 0; c < 8; ++c) raw[c] = *gp((const u32x4*)(ptr + 8 * c));
        float ss = 0.f;
#pragma unroll
        for (int c = 0; c < 8; ++c)
#pragma unroll
            for (int e = 0; e < 4; ++e) { v[8 * c + 2 * e] = bflo(raw[c][e]); v[8 * c + 2 * e + 1] = bfhi(raw[c][e]); }
#pragma unroll
        for (int d = 0; d < 64; ++d) ss += v[d] * v[d];
        const float rs = rsqrtf(ss * (1.0f / 64.0f) + 1e-6f);
#pragma unroll
        for (int d = 0; d < 64; ++d) v[d] = v[d] * rs * gn[d];
        const int pos = tok & (SEQ - 1);
#pragma unroll
        for (int f = 0; f < 8; ++f) { const float2 cs = rope[pos * 8 + f]; const float x1 = v[f], x2 = v[f + 8]; v[f] = x1 * cs.x - x2 * cs.y; v[f + 8] = x2 * cs.x + x1 * cs.y; }
#pragma unroll
        for (int c = 0; c < 8; ++c) { u32x4 w; w.x = pk2(v[8 * c], v[8 * c + 1]); w.y = pk2(v[8 * c + 2], v[8 * c + 3]); w.z = pk2(v[8 * c + 4], v[8 * c + 5]); w.w = pk2(v[8 * c + 6], v[8 * c + 7]); *(u32x4*)(ptr + 8 * c) = w; }
    }
    for (int i0 = gtid * 4; i0 < 2 * 4096 * 256; i0 += gsz * 4) {
        u32x4 raw[4]; f32x4 pa[4], pb[4];
#pragma unroll
        for (int u = 0; u < 4; ++u) {
            const int i = i0 + u, which = i >> 20, row = (i >> 8) & 4095, ch = i & 255;
            raw[u] = (u32x4){0u, 0u, 0u, 0u}; pa[u] = (f32x4){0.f, 0.f, 0.f, 0.f}; pb[u] = pa[u];
            if (row < 4064) {
                const int g = row & 3, bc = row >> 2, b = bc / 127, c = bc - b * 127, l = ch >> 3, d0 = (ch & 7) * 8;
                raw[u] = *gp((const u32x4*)(kvn + (size_t)(b * SEQ + 16 * c + l) * 1024 + which * 256 + g * 64 + d0));
                const float* pe = (which ? IN(14) : IN(13)) + l * 64 + d0;
                pa[u] = *gp((const f32x4*)pe); pb[u] = *gp((const f32x4*)(pe + 4));
            }
        }
#pragma unroll
        for (int u = 0; u < 4; ++u) {
            const int i = i0 + u, which = i >> 20, row = (i >> 8) & 4095, ch = i & 255;
            bf16_t* dst = (bf16_t*)(ws + WS_CMP + (size_t)which * 16 * MiB) + (size_t)row * 2048 + ch * 8;
            u32x4 w = {0u, 0u, 0u, 0u};
            if (row < 4064) {
                w.x = pk2(bflo(raw[u].x) + pa[u][0], bfhi(raw[u].x) + pa[u][1]); w.y = pk2(bflo(raw[u].y) + pa[u][2], bfhi(raw[u].y) + pa[u][3]);
                w.z = pk2(bflo(raw[u].z) + pb[u][0], bfhi(raw[u].z) + pb[u][1]); w.w = pk2(bflo(raw[u].w) + pb[u][2], bfhi(raw[u].w) + pb[u][3]);
            }
            *gpw((u32x4*)dst) = w;
        }
    }
}

DI void cmp2_phase(const Ctx& cx, const Params& p, LAS unsigned char* lds) {
    unsigned char* ws = p.ws;
    const f32x2* rope = (const f32x2*)(ws + WS_ROPE);
    bf16_t* kc = (bf16_t*)(ws + WS_KC); bf16_t* vct = (bf16_t*)(ws + WS_VCT);
    const int lane = cx.tid & 63, wid = cx.tid >> 6;
    LAS float* w2L = (LAS float*)lds;
    LAS unsigned char* hidL = lds + 65536;
    for (int which = 0; which < 2; ++which) {
        const float* w2 = which ? IN(18) : IN(16);
        for (int grp = cx.bid; grp < 256; grp += cx.nb) {
            __syncthreads();
#pragma unroll
            for (int i = 0; i < 8; ++i) { const int o = (cx.tid + 512 * i) * 4; *(LAS f32x4*)(w2L + o) = *gp((const f32x4*)(w2 + o)); }
            {
                const int rl = cx.tid >> 5, ch = cx.tid & 31, rp = grp * 16 + rl;
                const int g = rp & 3, c = (rp >> 2) & 127, b = rp >> 9;
                u32x4 hv = {0u, 0u, 0u, 0u};
                if (c < 127) hv = *gp((const u32x4*)((const bf16_t*)(ws + WS_CMP + 32 * MiB + (size_t)which * 2 * MiB) + (size_t)((b * 127 + c) * 4 + g) * 256 + ch * 8));
                *(LAS u32x4*)(hidL + rl * 512 + ch * 16) = hv;
            }
            __syncthreads();
            float acc[2] = {0.f, 0.f};
            for (int k = 0; k < 256; k += 4) {
                const u32x2 h0 = *(const LAS u32x2*)(hidL + (2 * wid) * 512 + k * 2), h1 = *(const LAS u32x2*)(hidL + (2 * wid + 1) * 512 + k * 2);
                const float w0 = w2L[(k + 0) * 64 + lane], w1 = w2L[(k + 1) * 64 + lane], w2v = w2L[(k + 2) * 64 + lane], w3 = w2L[(k + 3) * 64 + lane];
                acc[0] += bflo(h0.x) * w0; acc[0] += bfhi(h0.x) * w1; acc[0] += bflo(h0.y) * w2v; acc[0] += bfhi(h0.y) * w3;
                acc[1] += bflo(h1.x) * w0; acc[1] += bfhi(h1.x) * w1; acc[1] += bflo(h1.y) * w2v; acc[1] += bfhi(h1.y) * w3;
            }
#pragma unroll
            for (int rr = 0; rr < 2; ++rr) {
                const int rp = grp * 16 + 2 * wid + rr;
                const int g = rp & 3, c = (rp >> 2) & 127, b = rp >> 9, bg = b * 4 + g;
                const float a = acc[rr];
                if (which == 0) {
                    float ss = a * a;
#pragma unroll
                    for (int o = 32; o > 0; o >>= 1) ss += __shfl_xor(ss, o);
                    float v = a * rsqrtf(ss * (1.0f / 64.0f) + 1e-6f) * *gp(IN(12) + lane);
                    const float other = __shfl_xor(v, 8);
                    if (lane < 16 && c < 127) { const f32x2 cs = *gp(rope + (16 * c + 31) * 8 + (lane & 7)); v = (lane < 8) ? (v * cs[0] - other * cs[1]) : (v * cs[0] + other * cs[1]); }
                    *gpw(kc + (size_t)(bg * 128 + c) * 64 + lane) = (bf16_t)(pk2(c < 127 ? v : 0.f, 0.f) & 0xffffu);
                } else {
                    *gpw(vct + (size_t)(bg * 64 + lane) * 128 + c) = (bf16_t)(pk2(c < 127 ? a : 0.f, 0.f) & 0xffffu);
                }
            }
        }
    }
}

constexpr int NSA_SB_OFF = 16384, NSA_SB_BYTES = 17920, NSA_V_OFF = 9216;
DI void nsa_stage_load(const bf16_t* __restrict__ kbase, const bf16_t* __restrict__ vtbase, int tok0, int j, int tid, u32x4& kr, u32x4& vr) {
    const int row = tid >> 3, ch = tid & 7;
    kr = *gp((const u32x4*)(kbase + (size_t)(tok0 + 64 * j + row) * 1024 + ch * 8));
    vr = *gp((const u32x4*)(vtbase + (size_t)row * MTOK + tok0 + 64 * j + ch * 8));
}
DI void nsa_stage_write(LAS unsigned char* sb, int tid, const u32x4& kr, const u32x4& vr) {
    const int row = tid >> 3, ch = tid & 7;
    *(LAS u32x4*)(sb + row * 144 + ch * 16) = kr;
    LAS u32x2* vp = (LAS u32x2*)(sb + NSA_V_OFF + row * 136 + ch * 16);
    u32x2 a; a.x = vr.x; a.y = vr.y; u32x2 b; b.x = vr.z; b.y = vr.w;
    vp[0] = a; vp[1] = b;
}
DI void nsa_step(const bool EDGE, const LAS unsigned char* sb, int key0, float xinit, int lo, int hi, const bf16x8 (&qf)[4], f32x16 (&o)[2], float& lrun, int r, int h) {
    f32x16 x0, x1;
#pragma unroll
    for (int i = 0; i < 16; ++i) { x0[i] = xinit; x1[i] = xinit; }
#pragma unroll
    for (int s = 0; s < 4; ++s) {
        const bf16x8 k0 = *(const LAS bf16x8*)(sb + r * 144 + (16 * s + 8 * h) * 2);
        const bf16x8 k1 = *(const LAS bf16x8*)(sb + (32 + r) * 144 + (16 * s + 8 * h) * 2);
        x0 = MFMA32(k0, qf[s], x0);
        x1 = MFMA32(k1, qf[s], x1);
    }
    if (EDGE) {
#pragma unroll
        for (int i = 0; i < 16; ++i) {
            const int key = key0 + (i & 3) + 8 * (i >> 2) + 4 * h;
            x0[i] = (key >= lo && key <= hi) ? x0[i] : -1e30f;
            x1[i] = (key + 32 >= lo && key + 32 <= hi) ? x1[i] : -1e30f;
        }
    }
    float ls = 0.f;
#pragma unroll
    for (int i = 0; i < 16; ++i) { x0[i] = __builtin_amdgcn_exp2f(x0[i]); x1[i] = __builtin_amdgcn_exp2f(x1[i]); ls += x0[i] + x1[i]; }
    lrun += ls;
#pragma unroll
    for (int s2 = 0; s2 < 4; ++s2) {
        u32x4 pw;
        if (s2 < 2) { pw.x = pk2(x0[8 * s2 + 0], x0[8 * s2 + 1]); pw.y = pk2(x0[8 * s2 + 2], x0[8 * s2 + 3]); pw.z = pk2(x0[8 * s2 + 4], x0[8 * s2 + 5]); pw.w = pk2(x0[8 * s2 + 6], x0[8 * s2 + 7]); }
        else { const int q = s2 - 2; pw.x = pk2(x1[8 * q + 0], x1[8 * q + 1]); pw.y = pk2(x1[8 * q + 2], x1[8 * q + 3]); pw.z = pk2(x1[8 * q + 4], x1[8 * q + 5]); pw.w = pk2(x1[8 * q + 6], x1[8 * q + 7]); }
        const bf16x8 pf = __builtin_bit_cast(bf16x8, pw);
#pragma unroll
        for (int db = 0; db < 2; ++db) {
            const LAS unsigned char* vp = sb + NSA_V_OFF + (32 * db + r) * 136 + (16 * s2 + 4 * h) * 2;
            const s16x4 lo8 = *(const LAS s16x4*)vp, hi8 = *(const LAS s16x4*)(vp + 16);
            o[db] = MFMA32(__builtin_shufflevector(lo8, hi8, 0, 1, 2, 3, 4, 5, 6, 7), pf, o[db]);
        }
    }
}
DI int pop_bit(unsigned& rem) { if (!rem) return -1; const int j = __builtin_ctz(rem); rem &= rem - 1u; return j; }
DI void nsa_branch(const Ctx& cx, LAS unsigned char* lds, int& buf, const bf16_t* __restrict__ kbase, const bf16_t* __restrict__ vtbase, int tok0, int qt, int jedge2, int lo, int t,
                   unsigned selmask, unsigned wavemask, unsigned blockmask, const bf16x8 (&qf)[4], f32x16 (&o)[2], float shift, float& lrun, int r, int h) {
    unsigned rem = blockmask;
    int ja = pop_bit(rem), jb = pop_bit(rem);
    u32x4 kA, vA, kB, vB;
    nsa_stage_load(kbase, vtbase, tok0, ja, cx.tid, kA, vA);
    nsa_stage_load(kbase, vtbase, tok0, jb >= 0 ? jb : 0, cx.tid, kB, vB);
    for (;;) {
        {
            LAS unsigned char* sb = lds + NSA_SB_OFF + buf * NSA_SB_BYTES;
            nsa_stage_write(sb, cx.tid, kA, vA);
            lds_barrier();
            const int j = ja; ja = pop_bit(rem);
            nsa_stage_load(kbase, vtbase, tok0, ja >= 0 ? ja : 0, cx.tid, kA, vA);
            if ((wavemask >> j) & 1u) nsa_step((j == qt) || (j == jedge2), sb, 64 * j, ((selmask >> j) & 1u) ? shift : -1e30f, lo, t, qf, o, lrun, r, h);
            buf ^= 1;
        }
        if (jb < 0) break;
        {
            LAS unsigned char* sb = lds + NSA_SB_OFF + buf * NSA_SB_BYTES;
            nsa_stage_write(sb, cx.tid, kB, vB);
            lds_barrier();
            const int j = jb; jb = pop_bit(rem);
            nsa_stage_load(kbase, vtbase, tok0, jb >= 0 ? jb : 0, cx.tid, kB, vB);
            if ((wavemask >> j) & 1u) nsa_step((j == qt) || (j == jedge2), sb, 64 * j, ((selmask >> j) & 1u) ? shift : -1e30f, lo, t, qf, o, lrun, r, h);
            buf ^= 1;
        }
        if (ja < 0) break;
    }
}

DI float sel_score(float imp, int j, int cur) { const bool forced = (j == 0) || (j == cur) || (j == cur - 1); return forced ? 1e4f : (j <= cur ? imp : -1e4f); }

DI void nsa_attn_phase(const Ctx& cx, const Params& p, int li, LAS unsigned char* lds, float* ldsf) {
    unsigned char* ws = p.ws;
    const bf16_t* qg = (const bf16_t*)(ws + WS_S);
    bf16_t* ao = (bf16_t*)(ws + WS_S + 96 * MiB);
    const bf16_t* kvn = (const bf16_t*)(ws + WS_KVN); const bf16_t* kvT = (const bf16_t*)(ws + WS_KVT);
    const bf16_t* kc = (const bf16_t*)(ws + WS_KC); const bf16_t* vct = (const bf16_t*)(ws + WS_VCT);
    const float2* rope = (const float2*)(ws + WS_ROPE);
    const int lane = cx.tid & 63, wid = cx.tid >> 6, r = lane & 31, h = lane >> 5;
    LAS float* impL = (LAS float*)lds + wid * 256;
    LAS unsigned* selL = (LAS unsigned*)(lds + 8192) + wid * 8;
    float gmax1, gmax2;
    float gmax0;
    { float a0 = fabsf(*gp(IN(12) + lane));
#pragma unroll
      for (int o = 32; o > 0; o >>= 1) a0 = fmaxf(a0, __shfl_xor(a0, o));
      gmax0 = a0; }
    { float a1 = fabsf(IN(12)[64 + lane]), a2 = fabsf(IN(12)[128 + lane]);
#pragma unroll
      for (int o = 32; o > 0; o >>= 1) { a1 = fmaxf(a1, __shfl_xor(a1, o)); a2 = fmaxf(a2, __shfl_xor(a2, o)); }
      gmax1 = a1; gmax2 = a2; }
    int buf = 0, staged_bg = -1;
    constexpr int KC_OFF = 53248, VC_OFF = 71680, QN_OFF = 8704;
    const LAS float* qnL = (const LAS float*)(lds + QN_OFF);
    for (int e = cx.bid; e < 1024; e += cx.nb) {
        const int k4 = e >> 8, blk = e & 255, bg = (blk & 7) * 4 + (blk >> 6), u = (blk >> 3) & 7;
        const int qt = (k4 == 0) ? u : (k4 == 1) ? 15 - u : (k4 == 2) ? 16 + u : 31 - u;
        const int b = bg >> 2, g = bg & 3, tok0 = b * SEQ;
        const int ql = r >> 2, rr = r & 3, t = 64 * qt + 8 * wid + ql, head = 4 * g + rr;
        const size_t token = (size_t)(tok0 + t);
        if (bg != staged_bg) {
            __syncthreads();
#pragma unroll
            for (int i = 0; i < 2; ++i) {
                const int c = cx.tid + 512 * i;
                { const int row = c >> 3, ch = c & 7; *(LAS u32x4*)(lds + KC_OFF + row * 144 + ch * 16) = *gp((const u32x4*)(kc + (size_t)(bg * 128 + row) * 64 + ch * 8)); }
                { const int row = c >> 4, ch = c & 15; const u32x4 v = *gp((const u32x4*)(vct + (size_t)(bg * 64 + row) * 128 + ch * 8));
                  LAS u32x2* vp = (LAS u32x2*)(lds + VC_OFF + row * 264 + ch * 16); u32x2 a; a.x = v.x; a.y = v.y; u32x2 b2; b2.x = v.z; b2.y = v.w; vp[0] = a; vp[1] = b2; }
            }
            if (cx.tid < 64) ((LAS float*)(lds + QN_OFF))[cx.tid] = *gp(IN(20) + li * 64 + cx.tid);
            staged_bg = bg;
            __syncthreads();
        }
        bf16x8 qf[4]; float qn2 = 0.f;
        {
            float v[4][8]; float ss = 0.f;
#pragma unroll
            for (int s = 0; s < 4; ++s) {
                const u32x4 raw = *gp((const u32x4*)(qg + token * 1280 + head * 64 + 16 * s + 8 * h));
#pragma unroll
                for (int q = 0; q < 4; ++q) { v[s][2 * q] = bflo(raw[q]); v[s][2 * q + 1] = bfhi(raw[q]); }
#pragma unroll
                for (int j = 0; j < 8; ++j) ss += v[s][j] * v[s][j];
            }
            ss += __shfl_xor(ss, 32);
            const float rs = rsqrtf(ss * (1.0f / 64.0f) + 1e-6f);
#pragma unroll
            for (int s = 0; s < 4; ++s)
                { const f32x4 g0 = *(const LAS f32x4*)(qnL + 16 * s + 8 * h), g1 = *(const LAS f32x4*)(qnL + 16 * s + 8 * h + 4);
#pragma unroll
                  for (int j = 0; j < 4; ++j) { v[s][j] = v[s][j] * rs * g0[j]; v[s][4 + j] = v[s][4 + j] * rs * g1[j]; } }
#pragma unroll
            for (int j = 0; j < 8; ++j) {
                const f32x4 cs4 = *gp((const f32x4*)rope + t * 4 + (j >> 1)); const float2 cs = (j & 1) ? make_float2(cs4[2], cs4[3]) : make_float2(cs4[0], cs4[1]); const float pb = __shfl_xor(v[0][j], 32);
                v[0][j] = v[0][j] * cs.x + (h ? pb : -pb) * cs.y;
            }
#pragma unroll
            for (int s = 0; s < 4; ++s) { u32x4 w; const float qs = 0.125f * 1.4426950408889634f;
#pragma unroll
                for (int j = 0; j < 8; ++j) qn2 += (v[s][j] * qs) * (v[s][j] * qs);
                w.x = pk2(v[s][0] * qs, v[s][1] * qs); w.y = pk2(v[s][2] * qs, v[s][3] * qs); w.z = pk2(v[s][4] * qs, v[s][5] * qs); w.w = pk2(v[s][6] * qs, v[s][7] * qs); qf[s] = __builtin_bit_cast(bf16x8, w); }
        }
        qn2 += __shfl_xor(qn2, 32);
        const float qnorm = sqrtf(qn2);
        float gate[3];
#pragma unroll
        for (int br = 0; br < 3; ++br) { const float gl = bf2f(*gp(qg + token * 1280 + 1024 + br * 16 + g * 4 + rr)); gate[br] = __builtin_amdgcn_rcpf(1.0f + __expf(-gl)); }
        f32x16 fin[2];
        {
            const int nvalid = (t >= 31) ? (((t - 31) >> 4) + 1) : 0;
            f32x16 xc[4];
            const float cshift = -fminf(1.01f * qnorm * 8.0f * gmax0, 60.0f);
#pragma unroll
            for (int T = 0; T < 4; ++T) {
#pragma unroll
                for (int i = 0; i < 16; ++i) xc[T][i] = cshift;
#pragma unroll
                for (int s = 0; s < 4; ++s) {
                    const bf16x8 kf = *(const LAS bf16x8*)(lds + KC_OFF + (32 * T + r) * 144 + (16 * s + 8 * h) * 2);
                    xc[T] = MFMA32(kf, qf[s], xc[T]);
                }
            }
            float ls = 0.f;
            const int nvh = nvalid - 4 * h;
#pragma unroll
            for (int T = 0; T < 4; ++T)
#pragma unroll
                for (int i = 0; i < 16; ++i) { const float pv = (32 * T + (i & 3) + 8 * (i >> 2) < nvh) ? __builtin_amdgcn_exp2f(xc[T][i]) : 0.f; xc[T][i] = pv; ls += pv; }
            ls += __shfl_xor(ls, 32);
            const float inv = (nvalid > 0) ? 1.0f / ls : 0.f;
#pragma unroll
            for (int T = 0; T < 4; ++T)
#pragma unroll
                for (int i = 0; i < 16; ++i) xc[T][i] *= inv;
#pragma unroll
            for (int i = 0; i < 16; ++i) { fin[0][i] = 0.f; fin[1][i] = 0.f; }
#pragma unroll
            for (int T = 0; T < 4; ++T)
#pragma unroll
                for (int s2 = 0; s2 < 2; ++s2) {
                    u32x4 pw; pw.x = pk2(xc[T][8 * s2 + 0], xc[T][8 * s2 + 1]); pw.y = pk2(xc[T][8 * s2 + 2], xc[T][8 * s2 + 3]); pw.z = pk2(xc[T][8 * s2 + 4], xc[T][8 * s2 + 5]); pw.w = pk2(xc[T][8 * s2 + 6], xc[T][8 * s2 + 7]);
                    const bf16x8 pf = __builtin_bit_cast(bf16x8, pw);
#pragma unroll
                    for (int db = 0; db < 2; ++db) {
                        const LAS unsigned char* vp = lds + VC_OFF + (32 * db + r) * 264 + (32 * T + 16 * s2 + 4 * h) * 2;
                        const s16x4 lo = *(const LAS s16x4*)vp, hi = *(const LAS s16x4*)(vp + 16);
                        fin[db] = MFMA32(__builtin_shufflevector(lo, hi, 0, 1, 2, 3, 4, 5, 6, 7), pf, fin[db]);
                    }
                }
#pragma unroll
            for (int i = 0; i < 16; ++i) { fin[0][i] *= gate[0]; fin[1][i] *= gate[0]; }
            float pe[4][4];
#pragma unroll
            for (int T = 0; T < 4; ++T)
#pragma unroll
                for (int gq = 0; gq < 4; ++gq) pe[T][gq] = __shfl_xor(xc[T][4 * gq + 3], 32);
#pragma unroll
            for (int T = 0; T < 4; ++T)
#pragma unroll
                for (int gq = 0; gq < 4; ++gq) {
                    float extra;
                    if (h) extra = pe[T][gq];
                    else extra = (gq > 0) ? pe[T][gq - 1] : (T > 0 ? pe[T > 0 ? T - 1 : 0][3] : 0.f);
                    float im = (xc[T][4 * gq] + xc[T][4 * gq + 1]) + (xc[T][4 * gq + 2] + xc[T][4 * gq + 3]) + extra;
                    im += __shfl_xor(im, 1); im += __shfl_xor(im, 2);
                    if (rr == 0) { const int jsel = 8 * T + 2 * gq + h; impL[ql * 32 + jsel] = sel_score(im, jsel, qt); }
                }
        }
        __syncthreads();
        {
#pragma unroll 1
            for (int pass = 0; pass < 4; ++pass) {
                const int q2 = 2 * pass + h, jj = r;
                const float sc = impL[q2 * 32 + jj];
                const LAS f32x4* row = (const LAS f32x4*)(impL + q2 * 32);
                int rank = 0;
#pragma unroll
                for (int c4 = 0; c4 < 8; ++c4) {
                    const f32x4 v4 = row[c4];
#pragma unroll
                    for (int e4 = 0; e4 < 4; ++e4) { const int j2 = 4 * c4 + e4; rank += ((v4[e4] > sc) || (v4[e4] == sc && j2 < jj)) ? 1 : 0; }
                }
                const unsigned long long bal = __ballot(rank < 8);
                if (r == 0) selL[q2] = h ? (unsigned)(bal >> 32) : (unsigned)bal;
            }
        }
        __syncthreads();
        const unsigned qmask = (qt >= 31) ? 0xffffffffu : ((2u << qt) - 1u);
        const unsigned selmask = selL[ql] & qmask;
        unsigned wavemask = selmask;
#pragma unroll
        for (int o = 4; o < 32; o <<= 1) wavemask |= __shfl_xor(wavemask, o);
        unsigned blockmask = ((const LAS unsigned*)(lds + 8192))[lane] & qmask;
#pragma unroll
        for (int o = 1; o < 64; o <<= 1) blockmask |= __shfl_xor(blockmask, o);
        blockmask = __builtin_amdgcn_readfirstlane(blockmask);
#pragma unroll 1
        for (int br = 1; br <= 2; ++br) {
            f32x16 o[2];
#pragma unroll
            for (int i = 0; i < 16; ++i) { o[0][i] = 0.f; o[1][i] = 0.f; }
            float lrun = 0.f;
            const float shift = -fminf(1.01f * qnorm * 8.0f * (br == 1 ? gmax1 : gmax2), 60.0f);
            const int jlo = (br == 2 && qt > 8) ? qt - 8 : 0;
            const unsigned wmask = qmask & ~((1u << jlo) - 1u);
            const bf16_t* kb = kvn + (br == 1 ? 512 : 768) + g * 64;
            const bf16_t* vb = kvT + (size_t)((br == 1 ? 0 : 256) + g * 64) * MTOK;
            nsa_branch(cx, lds, buf, kb, vb, tok0, qt, (br == 2) ? qt - 8 : -100, (br == 2) ? t - 511 : -(1 << 30), t,
                       (br == 1) ? selmask : 0xffffffffu, (br == 1) ? wavemask : wmask, (br == 1) ? blockmask : wmask, qf, o, shift, lrun, r, h);
            lrun += __shfl_xor(lrun, 32);
            const float sc = ((br == 1) ? gate[1] : gate[2]) / lrun;
#pragma unroll
            for (int i = 0; i < 16; ++i) { fin[0][i] += o[0][i] * sc; fin[1][i] += o[1][i] * sc; }
        }
#pragma unroll
        for (int db = 0; db < 2; ++db)
#pragma unroll
            for (int gq = 0; gq < 4; ++gq) {
                u32x2 w; w.x = pk2(fin[db][4 * gq], fin[db][4 * gq + 1]); w.y = pk2(fin[db][4 * gq + 2], fin[db][4 * gq + 3]);
                *gpw((u32x2*)(ao + token * DM + head * 64 + 32 * db + 8 * gq + 4 * h)) = w;
            }
    }
}


#define XB_TMO      128
#define XB_XCNT(j)  (256  + 64 * (j))
#define XB_XSUB(j)  (1280 + 64 * (j))
#define XB_XGEN(j)  (2304 + 64 * (j))
#define XB_TOP      3328
#define XB_TOPGEN   3392
#define XCD_BAR_WORDS 3456
#define XB_SPIN_CAP (1u << 18)
DI unsigned xb_ld(unsigned* p)              { return __hip_atomic_load(p, __ATOMIC_RELAXED, __HIP_MEMORY_SCOPE_AGENT); }
DI unsigned xb_add(unsigned* p, unsigned v) { return __hip_atomic_fetch_add(p, v, __ATOMIC_RELAXED, __HIP_MEMORY_SCOPE_AGENT); }
DI unsigned xb_xcc_id() { return (unsigned)__builtin_amdgcn_s_getreg((3 << 11) | 20) & 0xFu; }
#define XB_SPIN(cond, bar) do { unsigned _sp = 0; while (cond) { __builtin_amdgcn_s_sleep(1); \
    if ((++_sp & 255u) == 0u) { if (xb_ld(&(bar)[XB_TMO])) break; if (_sp > XB_SPIN_CAP) { atomicAdd(&(bar)[XB_TMO], 1u); break; } } } } while (0)
struct XcdBarrier { unsigned* bar; unsigned x; volatile LAS unsigned* st; };
DI XcdBarrier xcd_barrier_post(unsigned* bar, volatile LAS unsigned* st) {
    XcdBarrier b; b.bar = bar; b.x = xb_xcc_id(); b.st = st;
    if (threadIdx.x == 0) (void)xb_add(&bar[XB_XCNT(b.x)], 1u);
    return b;
}
DI void xcd_barrier_complete(unsigned* bar, unsigned x, unsigned& nloc, unsigned& nx) {
    const unsigned G = gridDim.x * gridDim.y * gridDim.z;
    unsigned sum, cnt, mine, sp = 0u;
    for (;;) {
        sum = 0u; cnt = 0u; mine = 0u;
#pragma unroll
        for (unsigned j = 0; j < 16; ++j) { const unsigned c = xb_ld(&bar[XB_XCNT(j)]); sum += c; cnt += (c > 0u) ? 1u : 0u; mine = (j == x) ? c : mine; }
        if (sum == G) break;
        __builtin_amdgcn_s_sleep(1);
        if ((++sp & 255u) == 0u) { if (xb_ld(&bar[XB_TMO])) break; if (sp > XB_SPIN_CAP) { atomicAdd(&bar[XB_TMO], 1u); break; } }
    }
    nloc = mine > 0u ? mine : 1u; nx = cnt > 0u ? cnt : 1u;
}
DI void xcd_barrier(const XcdBarrier& b) {
    asm volatile("s_waitcnt vmcnt(0)" ::: "memory");
    __syncthreads();
    if (threadIdx.x == 0) {
        unsigned* bar = b.bar;
        __builtin_amdgcn_s_waitcnt(0);
        unsigned nloc = b.st[0], nx = b.st[1];
        if (nloc == 0u) { xcd_barrier_complete(bar, b.x, nloc, nx); b.st[0] = nloc; b.st[1] = nx; }
        const unsigned old = xb_add(&bar[XB_XSUB(b.x)], 1u);
        const unsigned gen = old / nloc;
        if (old + 1u == (gen + 1u) * nloc) {
            __builtin_amdgcn_fence(__ATOMIC_RELEASE, "agent");
            asm volatile("s_waitcnt vmcnt(0)" ::: "memory");
            const unsigned og = xb_add(&bar[XB_TOP], 1u);
            const unsigned tg = og / nx;
            if (og + 1u == (tg + 1u) * nx) xb_add(&bar[XB_TOPGEN], 1u);
            else XB_SPIN(xb_ld(&bar[XB_TOPGEN]) == tg, bar);
            __builtin_amdgcn_fence(__ATOMIC_ACQUIRE, "agent");
            xb_add(&bar[XB_XGEN(b.x)], 1u);
            asm volatile("s_waitcnt vmcnt(0)" ::: "memory");
        } else {
            XB_SPIN(xb_ld(&bar[XB_XGEN(b.x)]) == gen, bar);
            __builtin_amdgcn_fence(__ATOMIC_ACQUIRE, "agent");
            asm volatile("s_waitcnt vmcnt(0)" ::: "memory");
        }
    }
    __syncthreads();
}

struct GJob { const bf16_t* A; const bf16_t* Bt; int M, N, K, mode, coff; const u64* rowss; bf16_t* ob; int ldo; const float* hsrc; float* hdst; bf16_t* hb; u64* rowss_out; float alpha; };
DI bool get_job(const Ctx& cx, const Params& p, int L, int k, int i, GJob& J) {
    unsigned char* ws = p.ws;
    u64* rowss = (u64*)(ws + WS_RP);
    float* hbuf = (float*)(ws + WS_H);
    bf16_t* hb = (bf16_t*)(ws + WS_HB);
    bf16_t* S0 = (bf16_t*)(ws + WS_S);
    J.coff = 0; J.rowss = nullptr; J.ob = nullptr; J.ldo = 0; J.hsrc = nullptr; J.hdst = nullptr; J.hb = nullptr; J.rowss_out = nullptr; J.alpha = 0.f;
    if (k == 1 || k == 6) {
        if (i == 0) {
            J.mode = pg8::EP_U; J.A = hb; J.Bt = (const bf16_t*)(ws + (k == 1 ? WS_W1IN : WS_W2IN)); J.M = MTOK; J.N = NUP; J.K = DM;
            J.rowss = rowss + (size_t)(k == 1 ? 3 * L : 3 * L + 2) * MTOK; J.ob = S0; J.ldo = DFF; return true;
        }
        if (L == 2 && k == 1 && i == 1) {
            J.mode = pg8::EP_SCALE; J.A = hb; J.Bt = (const bf16_t*)(ws + WS_WKV); J.M = MTOK; J.N = 1024; J.K = DM; J.rowss = rowss + 6 * MTOK; J.ob = (bf16_t*)(ws + WS_KVN); J.ldo = 1024; return true;
        }
        if (L == 2 && k == 1 && i == 2) {
            J.mode = pg8::EP_SCALET; J.A = (const bf16_t*)(ws + WS_WKV + 2 * MiB); J.Bt = hb; J.M = 512; J.N = MTOK; J.K = DM; J.rowss = rowss + 6 * MTOK; J.ob = (bf16_t*)(ws + WS_KVT); J.ldo = MTOK; J.coff = cx.nb >> 1; return true;
        }
        return false;
    }
    if (k == 2 || k == 7 || k == 5) {
        if (i != 0) return false;
        const bool first = (L == 0 && k == 2), lastp = (L == 3 && k == 7);
        J.mode = pg8::EP_RES; J.M = MTOK; J.N = DM;
        J.hsrc = first ? IN(0) : nullptr; J.hdst = lastp ? p.out : nullptr; J.hb = hb;
        J.rowss_out = lastp ? nullptr : rowss + (size_t)(3 * L + (k == 2 ? 1 : k == 5 ? 2 : 3)) * MTOK; J.alpha = (k == 5) ? 1.0f : 0.5f;
        if (k == 5) { J.A = (const bf16_t*)(ws + WS_S + 96 * MiB); J.Bt = (const bf16_t*)(ws + WS_WMIX + 6 * MiB); J.K = DM; }
        else { J.A = S0; J.Bt = (const bf16_t*)(ws + (k == 2 ? WS_W1OUT : WS_W2OUT)); J.K = DFF; }
        return true;
    }
    if (k == 3) {
        if (L < 2) {
            if (i == 0) { J.mode = pg8::EP_SCALE; J.A = hb; J.Bt = (const bf16_t*)(ws + WS_WMIX); J.M = MTOK; J.N = 2048; J.K = DM; J.rowss = rowss + (size_t)(3 * L + 1) * MTOK; J.ob = S0; J.ldo = 2048; return true; }
            if (i == 1) { J.mode = pg8::EP_SCALET; J.A = (const bf16_t*)(ws + WS_WMIX + 4 * MiB); J.Bt = hb; J.M = 1024; J.N = MTOK; J.K = DM; J.rowss = rowss + (size_t)(3 * L + 1) * MTOK; J.ob = (bf16_t*)(ws + WS_S + 64 * MiB); J.ldo = MTOK; return true; }
            return false;
        }
        if (i == 0) { J.mode = pg8::EP_SCALE; J.A = hb; J.Bt = (const bf16_t*)(ws + WS_WMIX); J.M = MTOK; J.N = 1280; J.K = DM; J.rowss = rowss + (size_t)(3 * L + 1) * MTOK; J.ob = S0; J.ldo = 1280; return true; }
        if (L == 2 && (i == 1 || i == 2)) {
            J.mode = pg8::EP_SILU; J.A = (const bf16_t*)(ws + WS_CMP + (size_t)(i - 1) * 16 * MiB); J.Bt = (const bf16_t*)(ws + WS_WKV + (size_t)(2 + i) * MiB); J.M = 4096; J.N = 256; J.K = 2048;
            J.ob = (bf16_t*)(ws + WS_CMP + 32 * MiB + (size_t)(i - 1) * 2 * MiB); J.ldo = 256; J.coff = cx.nb - (i == 1 ? 64 : 80); return true;
        }
        return false;
    }
    return false;
}

namespace pg8 {
DI void epi_resolve(const EpiKey& key, EpiFields& f) {
    Params p; p.ws = launder_ptr(key.ws); p.out = key.out; p.in[0] = key.x;
    Ctx cx; cx.tid = 0; cx.bid = 0; cx.nb = key.nb; cx.plo = 0; cx.phi = 0x7fffffff; cx.pq = 0; cx.pst = key.nb;
    GJob J; (void)get_job(cx, p, key.L, key.k, key.i, J);
    f.rowss = J.rowss; f.ob = J.ob; f.ldo = J.ldo; f.hsrc = J.hsrc; f.hdst = J.hdst; f.hb = J.hb; f.hlo = (void*)(key.ws + WS_H); f.rowss_out = J.rowss_out; f.alpha = J.alpha;
}
}
DI void run_phase(const Ctx& cx, const Params& p, int ph, LAS unsigned char* lds, float* ldsf) {
    int L, k;
    if (ph < 8) { L = 0; k = ph; }
    else if (ph < 15) { L = 1; k = ph - 7; }
    else if (ph < 23) { L = 2; const int i = ph - 15; k = (i < 3) ? i + 1 : (i == 3 ? 8 : i); }
    else { L = 3; k = ph - 22; }
    if (k == 0) { prep_phase(cx, p, L, (LAS float*)lds); return; }
    if (k == 4) { if (L < 2) sb_attn_phase(cx, p); else nsa_attn_phase(cx, p, L - 2, lds, ldsf); return; }
    if (k == 8) { cmp2_phase(cx, p, lds); return; }
    if (k == 1 || (k == 6 && L < 3)) {
        Ctx cv = cx;
        const int nrem = (MTOK / 256) * (NUP / 256) % cx.nb;
        if (cx.nb == 256 && nrem == 128 && !(L == 2 && k == 1)) {
            const int NT = (k == 1) ? (1408 + (L == 0 ? 512 : 0)) : (704 + (L + 1 < 2 ? 512 : 288));
            const int g = cx.bid >> 6;
            const int b0 = 0, b1 = 0, b2 = (NT * 6) / 100, b3 = (NT * 50) / 100, b4 = 0x7fffffff;
            cv.plo = (g == 0) ? b0 : (g == 1) ? b1 : (g == 2) ? b2 : b3;
            cv.phi = (g == 0) ? b1 : (g == 1) ? b2 : (g == 2) ? b3 : b4;
            cv.pq = cx.bid & 63; cv.pst = 64;
        }
        int tb = 0;
        if (k == 1) { prep_w1out(cv, p, L, (LAS float*)lds, tb); if (L == 0) prep_wmix(cv, p, 0, (LAS float*)lds, tb); if (L != 2) prep_w2(cv, p, L, (LAS float*)lds, tb); }
        else { prep_w1in(cv, p, L + 1, (LAS float*)lds, tb); prep_wmix(cv, p, L + 1, (LAS float*)lds, tb); }
        __syncthreads();
    }
#pragma unroll 1
    for (int i = 0; i < 3; ++i) {
        GJob J;
        if (!get_job(cx, p, L, k, i, J)) break;
        pg8::Gemm g; g.A = J.A; g.Bt = J.Bt; g.M = J.M; g.N = J.N; g.K = J.K;
        pg8::StaticOrder S; S.init(J.M, J.N, cx.nb, (cx.bid + J.coff) % cx.nb);
        pg8::EpiKey key; key.ws = p.ws; key.out = p.out; key.x = p.in[0]; key.L = L; key.k = k; key.i = i; key.nb = cx.nb;
        switch (J.mode) {
        case pg8::EP_U: { pg8::Epi<pg8::EP_U> E; E.key = key; pg8::gemm_phase(cx, lds, g, S, E, J.rowss); } break;
        case pg8::EP_RES: { pg8::Epi<pg8::EP_RES> E; E.key = key; pg8::gemm_phase(cx, lds, g, S, E); } break;
        case pg8::EP_SCALE: { pg8::Epi<pg8::EP_SCALE> E; E.key = key; pg8::gemm_phase(cx, lds, g, S, E, J.rowss); } break;
        case pg8::EP_SCALET: { pg8::Epi<pg8::EP_SCALET> E; E.key = key; pg8::gemm_phase(cx, lds, g, S, E, J.rowss); } break;
        default: { pg8::Epi<pg8::EP_SILU> E; E.key = key; pg8::gemm_phase(cx, lds, g, S, E); } break;
        }
    }
    if (L == 2 && k == 2) kv_prep_phase(cx, p);
    if (L == 2 && k == 3 && cx.nb > 96 && cx.bid >= 96) {
        Ctx cv = cx; cv.plo = 0; cv.phi = 0x7fffffff; cv.pq = cx.bid - 96; cv.pst = cx.nb - 96;
        int tb = 0; __syncthreads();
        prep_w2(cv, p, 2, (LAS float*)lds, tb);
    } else if (L == 2 && k == 3 && cx.nb <= 96) { int tb = 0; __syncthreads(); prep_w2(cx, p, 2, (LAS float*)lds, tb); }
}

__global__ void __launch_bounds__(512, 2) mk_fwd(Params p, int ph_lo, int ph_hi) {
    extern __shared__ __attribute__((aligned(16))) unsigned char shm[];
    LAS unsigned char* lds = (LAS unsigned char*)shm;
    float* ldsf = (float*)shm;
    if (threadIdx.x < 4) ((volatile LAS unsigned*)(lds + LDS_STAGE))[threadIdx.x] = 0u;
    __syncthreads();
    const unsigned xb_x = __builtin_amdgcn_readfirstlane(xcd_barrier_post((unsigned*)(p.ws + WS_BAR), (volatile LAS unsigned*)(lds + LDS_STAGE)).x);
    if (ph_lo < 0) cg::this_grid().sync();
    const unsigned wave_s = __builtin_amdgcn_readfirstlane(threadIdx.x >> 6);
    for (int ph = ph_lo; ph < ph_hi; ++ph) {
        Ctx cx; { unsigned ln; asm volatile("v_mbcnt_lo_u32_b32 %0, -1, 0\n\tv_mbcnt_hi_u32_b32 %0, -1, %0" : "=v"(ln)); cx.tid = (int)((launder_u32(wave_s) << 6) | ln); }
        cx.bid = (int)launder_u32(blockIdx.x); cx.nb = (int)launder_u32(gridDim.x); cx.plo = 0; cx.phi = 0x7fffffff; cx.pq = cx.bid; cx.pst = cx.nb;
        Params q = p;
        { const unsigned long long ka = (unsigned long long)__builtin_amdgcn_kernarg_segment_ptr(); unsigned long long wsv, outv;
          asm volatile("s_load_dwordx2 %0, %2, 0xb8\n\ts_load_dwordx2 %1, %2, 0xb0\n\ts_waitcnt lgkmcnt(0)" : "=&s"(wsv), "=&s"(outv) : "s"(ka) : "memory");
          q.ws = (unsigned char*)wsv; q.out = (float*)outv; }
        run_phase(cx, q, ph, lds, ldsf);
        if (ph + 1 < ph_hi) { XcdBarrier xbl; xbl.bar = (unsigned*)(q.ws + WS_BAR); xbl.x = launder_u32(xb_x); xbl.st = (volatile LAS unsigned*)(lds + LDS_STAGE); xcd_barrier(xbl); }
    }
}

extern "C" void kernel_launch(void* const* d_in, const int* in_sizes, int n_in, void* d_out, int out_size, void* d_ws, size_t ws_size, hipStream_t stream) {
    static int grid = 0;
    if (grid == 0) {
        if (n_in != 22 || ws_size < WS_END) { fprintf(stderr, "kernel_launch: unexpected n_in %d / ws_size %zu (need %zu)\n", n_in, ws_size, (size_t)WS_END); grid = -1; return; }
        int dev = 0, cus = 0, per_cu = 0;
        hipGetDevice(&dev);
        hipDeviceGetAttribute(&cus, hipDeviceAttributeMultiprocessorCount, dev);
        if (hipFuncSetAttribute((const void*)mk_fwd, hipFuncAttributeMaxDynamicSharedMemorySize, LDS_BYTES) != hipSuccess) { fprintf(stderr, "kernel_launch: hipFuncSetAttribute failed\n"); grid = -1; return; }
        hipOccupancyMaxActiveBlocksPerMultiprocessor(&per_cu, (const void*)mk_fwd, 512, LDS_BYTES);
        if (per_cu < 1) { fprintf(stderr, "kernel_launch: occupancy query says %d blocks/CU\n", per_cu); per_cu = 1; }
        grid = cus * per_cu;
        (void)hipGetLastError();
    }
    if (grid < 0) return;
    if (hipMemsetAsync((char*)d_ws + WS_BAR, 0, XCD_BAR_WORDS * 4, stream) != hipSuccess) { fprintf(stderr, "kernel_launch: memset of barrier words failed\n"); return; }
    Params p{};
    for (int i = 0; i < 22; ++i) p.in[i] = (const float*)d_in[i];
    p.out = (float*)d_out; p.ws = (unsigned char*)d_ws;
#if MK_COOP
    int lo = 0, hi = NPH;
    void* args[] = {&p, &lo, &hi};
    hipError_t e = hipLaunchCooperativeKernel((const void*)mk_fwd, dim3(grid), dim3(512), args, LDS_BYTES, stream);
    if (e != hipSuccess) fprintf(stderr, "cooperative launch failed: %s (grid %d)\n", hipGetErrorString(e), grid);
#else
    for (int ph = 0; ph < NPH; ++ph) hipLaunchKernelGGL(mk_fwd, dim3(grid), dim3(512), LDS_BYTES, stream, p, ph, ph + 1);
#endif
}
```
